# Optimizing an MI355X kernel written in HIP

```python
import jax, jax.numpy as jnp
from jax import lax
import numpy as np

D_MODEL = 1024
BATCH = 4
SEQ = 4096
DEPTH = 1

CHUNK = 64
MEM_LEN = 256
CONV_WIDTH = D_MODEL // 2
CONV_K = 3
SB_HEADS = 8
SB_HEAD_DIM = 64
SB_WIDTH = SB_HEADS * SB_HEAD_DIM
MIX_WIDTH = CONV_WIDTH + SB_WIDTH
Q_BLOCK = 128
XA_HEADS = 4
XA_HEAD_DIM = D_MODEL // XA_HEADS
XA_WIDTH = XA_HEADS * XA_HEAD_DIM
N_EXPERTS = 32
TOP_K = 4
D_EXPERT = D_MODEL
SWIGLU_ALPHA = 1.702
SWIGLU_LIMIT = 7.0
MOE_BLOCK = 128
EPS = 1e-6

kernel_name = "hybrid_shortconv_stickbreaking_memxattn_moe"


def rms_norm(x, g):
    xf = x.astype(jnp.float32)
    y = xf * lax.rsqrt(jnp.mean(xf * xf, axis=-1, keepdims=True) + EPS)
    return (y * g.astype(jnp.float32)).astype(x.dtype)


def short_gated_conv(u, gate_b, gate_c, w_conv):
    v = gate_c * u
    y = lax.conv_general_dilated(
        v, w_conv[:, None, :].astype(v.dtype), window_strides=(1,),
        padding=[(CONV_K - 1, 0)], dimension_numbers=("NWC", "WIO", "NWC"),
        feature_group_count=v.shape[-1])
    return gate_b * y


def stick_breaking_attention(q, k, v):
    S, dh = q.shape[2], q.shape[3]
    scale = dh ** -0.5
    outs = []
    for q0 in range(0, S, Q_BLOCK):
        q1 = q0 + Q_BLOCK
        kb, vb = k[:, :, :q1], v[:, :, :q1]
        z = jnp.einsum("bhqd,bhkd->bhqk", q[:, :, q0:q1], kb).astype(jnp.float32) * scale
        t_pos = jnp.arange(q0, q1)[:, None]
        s_pos = jnp.arange(q1)[None, :]
        mask = s_pos < t_pos
        log_keep = jnp.where(mask, jax.nn.log_sigmoid(-z), 0.0)
        after = lax.cumsum(log_keep, axis=3, reverse=True) - log_keep
        a = jnp.where(mask, jnp.exp(jax.nn.log_sigmoid(z) + after), 0.0)
        outs.append(jnp.einsum("bhqk,bhkd->bhqd", a.astype(vb.dtype), vb))
    return jnp.concatenate(outs, axis=2)


def hybrid_mixer(h, w_in, w_conv, g_conv_out, g_sb_out, w_out):
    bsz, S, _ = h.shape
    proj = h @ w_in
    cw, sw = CONV_WIDTH, SB_WIDTH
    splits = [cw, 2 * cw, 3 * cw, 3 * cw + sw, 3 * cw + 2 * sw]
    u, gate_b, gate_c, q, k, v = jnp.split(proj, splits, axis=-1)
    y_conv = rms_norm(short_gated_conv(u, gate_b, gate_c, w_conv), g_conv_out)

    def heads(t):
        return t.reshape(bsz, S, SB_HEADS, SB_HEAD_DIM).transpose(0, 2, 1, 3)

    o = stick_breaking_attention(heads(q), heads(k), heads(v)).transpose(0, 2, 1, 3)
    y_sb = rms_norm(o, g_sb_out.reshape(SB_HEADS, SB_HEAD_DIM)).reshape(bsz, S, SB_WIDTH)
    return jnp.concatenate([y_conv, y_sb], axis=-1) @ w_out


def memory_cross_attention(h, m, w_xq, w_xkv, w_xo):
    bsz, S, _ = h.shape
    n_mem = m.shape[1]
    q = (h @ w_xq).reshape(bsz, S, XA_HEADS, XA_HEAD_DIM)
    kv = (m @ w_xkv).reshape(bsz, n_mem, 2, XA_HEADS, XA_HEAD_DIM)
    k, v = kv[:, :, 0], kv[:, :, 1]
    s = jnp.einsum("bqhd,bkhd->bhqk", q, k).astype(jnp.float32) * (XA_HEAD_DIM ** -0.5)
    p = jax.nn.softmax(s, axis=-1).astype(v.dtype)
    o = jnp.einsum("bhqk,bkhd->bqhd", p, v).reshape(bsz, S, XA_WIDTH)
    return o @ w_xo


def moe_ffn(h, w_router, b_router, w_gate_up, b_gate_up, w_down, b_down):
    n_tok, d = h.shape
    logits = (h @ w_router).astype(jnp.float32) + b_router.astype(jnp.float32)
    top_val, top_idx = lax.top_k(logits, TOP_K)
    gates = jax.nn.softmax(top_val, axis=-1).astype(h.dtype)
    n_assign = n_tok * TOP_K
    flat_e = top_idx.reshape(-1)
    flat_tok = jnp.arange(n_assign, dtype=jnp.int32) // TOP_K
    flat_g = gates.reshape(-1)
    order = jnp.argsort(flat_e)
    sorted_e = flat_e[order]
    counts = jnp.bincount(flat_e, length=N_EXPERTS)
    group_start = jnp.cumsum(counts) - counts
    padded = (counts + MOE_BLOCK - 1) // MOE_BLOCK * MOE_BLOCK
    padded_end = jnp.cumsum(padded)
    padded_start = padded_end - padded
    dest = padded_start[sorted_e] + jnp.arange(n_assign) - group_start[sorted_e]
    n_blocks = -(-n_assign // MOE_BLOCK) + N_EXPERTS
    n_rows = n_blocks * MOE_BLOCK
    row_tok = jnp.zeros((n_rows,), jnp.int32).at[dest].set(flat_tok[order])
    row_gate = jnp.zeros((n_rows,), h.dtype).at[dest].set(flat_g[order])
    block_e = jnp.minimum(
        jnp.searchsorted(padded_end, jnp.arange(n_blocks) * MOE_BLOCK, side="right"),
        N_EXPERTS - 1)
    xb = h[row_tok].reshape(n_blocks, MOE_BLOCK, d)

    def expert_block(args):
        xe, e = args
        gu = xe @ w_gate_up[e] + b_gate_up[e]
        g = jnp.minimum(gu[:, 0::2], SWIGLU_LIMIT)
        up = jnp.clip(gu[:, 1::2], -SWIGLU_LIMIT, SWIGLU_LIMIT)
        glu = g * jax.nn.sigmoid(g * SWIGLU_ALPHA)
        return ((up + 1.0) * glu) @ w_down[e] + b_down[e]

    yb = lax.map(expert_block, (xb, block_e)).reshape(n_rows, d)
    return jnp.zeros_like(h).at[row_tok].add(yb * row_gate[:, None])


def setup_inputs(seed: int = 0) -> dict:
    key = jax.random.key(seed)
    ks = jax.random.split(key, 24)
    f32 = jnp.float32
    L = DEPTH

    def nrm(k, shape, scale):
        return jax.random.normal(k, shape, f32) * scale

    def gain(k, shape):
        return 1.0 + 0.05 * jax.random.normal(k, shape, f32)

    return {
        "x": nrm(ks[0], (BATCH, SEQ, D_MODEL), 1.0),
        "mem": nrm(ks[1], (BATCH, MEM_LEN, D_MODEL), 1.0),
        "g_mix": gain(ks[2], (L, D_MODEL)),
        "w_in": nrm(ks[3], (L, D_MODEL, 3 * MIX_WIDTH), D_MODEL ** -0.5),
        "w_conv": nrm(ks[4], (L, CONV_K, CONV_WIDTH), CONV_K ** -0.5),
        "g_conv_out": gain(ks[5], (L, CONV_WIDTH)),
        "g_sb_out": gain(ks[6], (L, SB_WIDTH)),
        "w_out": nrm(ks[7], (L, MIX_WIDTH, D_MODEL), MIX_WIDTH ** -0.5),
        "g_xattn": gain(ks[8], (L, D_MODEL)),
        "g_mem": gain(ks[9], (L, D_MODEL)),
        "w_xq": nrm(ks[10], (L, D_MODEL, XA_WIDTH), D_MODEL ** -0.5),
        "w_xkv": nrm(ks[11], (L, D_MODEL, 2 * XA_WIDTH), D_MODEL ** -0.5),
        "w_xo": nrm(ks[12], (L, XA_WIDTH, D_MODEL), XA_WIDTH ** -0.5),
        "g_ffn": gain(ks[13], (L, D_MODEL)),
        "w_router": nrm(ks[14], (L, D_MODEL, N_EXPERTS), D_MODEL ** -0.5),
        "b_router": nrm(ks[15], (L, N_EXPERTS), 0.01),
        "w_gate_up": nrm(ks[16], (L, N_EXPERTS, D_MODEL, 2 * D_EXPERT), D_MODEL ** -0.5),
        "b_gate_up": nrm(ks[17], (L, N_EXPERTS, 2 * D_EXPERT), 0.01),
        "w_down": nrm(ks[18], (L, N_EXPERTS, D_EXPERT, D_MODEL), D_EXPERT ** -0.5),
        "b_down": nrm(ks[19], (L, N_EXPERTS, D_MODEL), 0.01),
        "g_final": gain(ks[20], (D_MODEL,)),
    }


def reference(x, mem, g_mix, w_in, w_conv, g_conv_out, g_sb_out, w_out, g_xattn, g_mem,
              w_xq, w_xkv, w_xo, g_ffn, w_router, b_router, w_gate_up, b_gate_up,
              w_down, b_down, g_final):
    bsz, S, d = x.shape
    for l in range(DEPTH):
        h = rms_norm(x, g_mix[l])
        x = x + hybrid_mixer(h, w_in[l], w_conv[l], g_conv_out[l], g_sb_out[l], w_out[l])
        h = rms_norm(x, g_xattn[l])
        m = rms_norm(mem, g_mem[l])
        x = x + memory_cross_attention(h, m, w_xq[l], w_xkv[l], w_xo[l])
        h = rms_norm(x, g_ffn[l]).reshape(bsz * S, d)
        x = x + moe_ffn(h, w_router[l], b_router[l], w_gate_up[l], b_gate_up[l],
                        w_down[l], b_down[l]).reshape(bsz, S, d)
    return rms_norm(x, g_final)
```

```cpp
#include <hip/hip_runtime.h>
#include <cstdio>
#include <cstdint>

#define GAS __attribute__((address_space(1)))
#define LAS __attribute__((address_space(3)))
typedef unsigned short bf16;
typedef unsigned v4u __attribute__((ext_vector_type(4)));
typedef unsigned v2u __attribute__((ext_vector_type(2)));
typedef float f32x4 __attribute__((ext_vector_type(4)));
typedef GAS unsigned gu32;
#define RLX_AGENT __ATOMIC_RELAXED, __HIP_MEMORY_SCOPE_AGENT
#define LDS_WAIT() asm volatile("s_waitcnt lgkmcnt(0)" ::: "memory")
#define VM_WAIT() asm volatile("s_waitcnt vmcnt(0)" ::: "memory")

constexpr int BATCH = 4, SEQ = 4096, D = 1024, NTOK = BATCH * SEQ, MEML = 256, NMEM = BATCH * MEML;
constexpr int CW = 512, SBH = 8, SBD = 64, NPROJ = 3072;
constexpr int PQ = 1536, PK = 2048, PV = 2560;
constexpr int XAH = 4, XAD = 256;
constexpr int NE = 32, TOPK = 4, NGU = 2048;
constexpr float EPS = 1e-6f;
constexpr int MAXT = 288, MAXROWS = MAXT * 256;
constexpr float QXSCALE = 0.0625f * 1.4426950408889634f;
constexpr float SBQSCALE = 0.125f * 1.4426950408889634f;
constexpr int NWAVES = 8;

constexpr size_t MiB = 1u << 20;
constexpr size_t WS_CTL = 0, CTL_ZERO_BYTES = 1 * MiB;
constexpr size_t WS_WIN = 2 * MiB, WS_WOUT = 8 * MiB, WS_WXQ = 10 * MiB, WS_WXKV = 12 * MiB, WS_WXO = 16 * MiB;
constexpr size_t WS_MN = 18 * MiB, WS_KVX = 20 * MiB, WS_VXT = 24 * MiB, WS_MISC = 26 * MiB;
constexpr size_t WS_WGU = 32 * MiB, WS_WD = 160 * MiB, WS_XN = 224 * MiB, WS_PROJ = 256 * MiB, WS_YMIX = 352 * MiB;
constexpr size_t WS_XA = 384 * MiB, WS_QX = 416 * MiB, WS_PX = 448 * MiB, WS_OX = 480 * MiB;
constexpr size_t WS_XG = 512 * MiB, WS_ACT = 656 * MiB, WS_Y = 800 * MiB, WS_END = 944 * MiB;
constexpr size_t MS_SSP1 = 0, MS_RSTD2 = 256 * 1024, MS_TOPI = 320 * 1024, MS_GATE = 576 * 1024, MS_CNT = 832 * 1024, MS_SLOT = 864 * 1024,
                 MS_RTOK = 1120 * 1024, MS_RGATE = 1408 * 1024, MS_TEXP = 1696 * 1024, MS_NT = 1700 * 1024;
constexpr int CW_BAR = 4096;

__device__ __forceinline__ float bf2f(unsigned v) { return __uint_as_float(v << 16); }
__device__ __forceinline__ unsigned f2bf(float f) { unsigned u = __builtin_bit_cast(unsigned, f); return (u + 0x7fffu + ((u >> 16) & 1u)) >> 16; }
__device__ __forceinline__ unsigned pk2(float lo, float hi) { return f2bf(lo) | (f2bf(hi) << 16); }
__device__ __forceinline__ float wave_sum(float v) {
#pragma unroll
    for (int o = 1; o < 64; o <<= 1) v += __shfl_xor(v, o);
    return v;
}
__device__ __forceinline__ float wave_max(float v) {
#pragma unroll
    for (int o = 1; o < 64; o <<= 1) v = fmaxf(v, __shfl_xor(v, o));
    return v;
}
__device__ __forceinline__ void unpack8(v4u w, float* f) {
    f[0] = bf2f(w.x & 0xffffu); f[1] = bf2f(w.x >> 16); f[2] = bf2f(w.y & 0xffffu); f[3] = bf2f(w.y >> 16);
    f[4] = bf2f(w.z & 0xffffu); f[5] = bf2f(w.z >> 16); f[6] = bf2f(w.w & 0xffffu); f[7] = bf2f(w.w >> 16);
}

__device__ __forceinline__ void st16_wt(void* p, v4u v) { asm volatile("global_store_dwordx4 %0, %1, off sc1\n\ts_nop 1" :: "v"(p), "v"(v) : "memory"); }

#define XB_TMO      128
#define XB_XCNT(j)  (256  + 64 * (j))
#define XB_XSUB(j)  (1280 + 64 * (j))
#define XB_XGEN(j)  (2304 + 64 * (j))
#define XB_TOP      3328
#define XB_TOPGEN   3392
#define XCD_BAR_WORDS 3456
#define XB_SPIN_CAP (1u << 18)
__device__ __forceinline__ unsigned xb_ld(unsigned* p)              { return __hip_atomic_load(p, __ATOMIC_RELAXED, __HIP_MEMORY_SCOPE_AGENT); }
__device__ __forceinline__ unsigned xb_add(unsigned* p, unsigned v) { return __hip_atomic_fetch_add(p, v, __ATOMIC_RELAXED, __HIP_MEMORY_SCOPE_AGENT); }
__device__ __forceinline__ unsigned xb_xcc_id() { return (unsigned)__builtin_amdgcn_s_getreg((3 << 11) | 20) & 0xFu; }
#define XB_SPIN(cond, bar) do { unsigned _sp = 0; while (cond) { __builtin_amdgcn_s_sleep(1); \
    if ((++_sp & 255u) == 0u) { if (xb_ld(&(bar)[XB_TMO])) break; if (_sp > XB_SPIN_CAP) { atomicAdd(&(bar)[XB_TMO], 1u); break; } } } } while (0)
struct XcdBarrier { unsigned* bar; unsigned x; volatile LAS unsigned* st; };
__device__ __forceinline__ XcdBarrier xcd_barrier_post(unsigned* bar, volatile LAS unsigned* st) {
    XcdBarrier b; b.bar = bar; b.x = xb_xcc_id(); b.st = st;
    if (threadIdx.x == 0) (void)xb_add(&bar[XB_XCNT(b.x)], 1u);
    return b;
}
__device__ __forceinline__ void xcd_barrier_complete(unsigned* bar, unsigned x, unsigned& nloc, unsigned& nx) {
    const unsigned G = gridDim.x * gridDim.y * gridDim.z;
    unsigned sum, cnt, mine, sp = 0u;
    for (;;) {
        sum = 0u; cnt = 0u; mine = 0u;
#pragma unroll
        for (unsigned j = 0; j < 16; ++j) { const unsigned c = xb_ld(&bar[XB_XCNT(j)]); sum += c; cnt += (c > 0u) ? 1u : 0u; mine = (j == x) ? c : mine; }
        if (sum == G) break;
        __builtin_amdgcn_s_sleep(1);
        if ((++sp & 255u) == 0u) { if (xb_ld(&bar[XB_TMO])) break; if (sp > XB_SPIN_CAP) { atomicAdd(&bar[XB_TMO], 1u); break; } }
    }
    nloc = mine > 0u ? mine : 1u; nx = cnt > 0u ? cnt : 1u;
}
__device__ __forceinline__ void xcd_barrier(const XcdBarrier& b) {
    asm volatile("s_waitcnt vmcnt(0)" ::: "memory");
    __syncthreads();
    if (threadIdx.x == 0) {
        unsigned* bar = b.bar;
        __builtin_amdgcn_s_waitcnt(0);
        unsigned nloc = b.st[0], nx = b.st[1];
        if (nloc == 0u) { xcd_barrier_complete(bar, b.x, nloc, nx); b.st[0] = nloc; b.st[1] = nx; }
        const unsigned old = xb_add(&bar[XB_XSUB(b.x)], 1u);
        const unsigned gen = old / nloc;
        if (old + 1u == (gen + 1u) * nloc) {
            __builtin_amdgcn_fence(__ATOMIC_RELEASE, "agent");
            asm volatile("s_waitcnt vmcnt(0)" ::: "memory");
            const unsigned og = xb_add(&bar[XB_TOP], 1u);
            const unsigned target = (og / nx + 1u) * nx;
            if (og + 1u != target) XB_SPIN(xb_ld(&bar[XB_TOP]) < target, bar);
            __builtin_amdgcn_fence(__ATOMIC_ACQUIRE, "agent");
            xb_add(&bar[XB_XGEN(b.x)], 1u);
            asm volatile("s_waitcnt vmcnt(0)" ::: "memory");
        } else {
            XB_SPIN(xb_ld(&bar[XB_XGEN(b.x)]) == gen, bar);
            __builtin_amdgcn_fence(__ATOMIC_ACQUIRE, "agent");
            asm volatile("s_waitcnt vmcnt(0)" ::: "memory");
        }
    }
    __syncthreads();
}

constexpr int RING_BYTES = 131072, LDSCTL_OFF = RING_BYTES, MISC_OFF = LDSCTL_OFF + 320, LDS_BYTES = 147456;
struct Args { const float* in[21]; float* out; unsigned char* ws; int ph_lo, ph_hi; };
struct Frame {
    LAS unsigned char* lds;
    int tid, lane, wave, vcu, G;
    const Args& a;
    __device__ __forceinline__ Frame(const Args& a_) : a(a_) {}
    __device__ __forceinline__ const float* x() const { return a.in[0]; }
    __device__ __forceinline__ const float* mem() const { return a.in[1]; }
    __device__ __forceinline__ const float* g_mix() const { return a.in[2]; }
    __device__ __forceinline__ const float* w_in() const { return a.in[3]; }
    __device__ __forceinline__ const float* w_conv() const { return a.in[4]; }
    __device__ __forceinline__ const float* g_conv() const { return a.in[5]; }
    __device__ __forceinline__ const float* g_sb() const { return a.in[6]; }
    __device__ __forceinline__ const float* w_out() const { return a.in[7]; }
    __device__ __forceinline__ const float* g_xattn() const { return a.in[8]; }
    __device__ __forceinline__ const float* g_mem() const { return a.in[9]; }
    __device__ __forceinline__ const float* w_xq() const { return a.in[10]; }
    __device__ __forceinline__ const float* w_xkv() const { return a.in[11]; }
    __device__ __forceinline__ const float* w_xo() const { return a.in[12]; }
    __device__ __forceinline__ const float* g_ffn() const { return a.in[13]; }
    __device__ __forceinline__ const float* w_router() const { return a.in[14]; }
    __device__ __forceinline__ const float* b_router() const { return a.in[15]; }
    __device__ __forceinline__ const float* w_gu() const { return a.in[16]; }
    __device__ __forceinline__ const float* b_gu() const { return a.in[17]; }
    __device__ __forceinline__ const float* w_down() const { return a.in[18]; }
    __device__ __forceinline__ const float* b_down() const { return a.in[19]; }
    __device__ __forceinline__ const float* g_final() const { return a.in[20]; }
    __device__ __forceinline__ float* out() const { return a.out; }
    __device__ __forceinline__ int* LTOK() const { return (int*)(a.ws + WS_XG); }
    __device__ __forceinline__ float* LGATE() const { return (float*)(a.ws + WS_XG + 2 * MiB); }
    __device__ __forceinline__ unsigned char* XB8() const { return a.ws + WS_XG + 4 * MiB; }
    __device__ __forceinline__ bf16* X2B() const { return (bf16*)(a.ws + WS_XG + 40 * MiB); }
    __device__ __forceinline__ unsigned char* Mt8() const { return a.ws + WS_QX; }
    __device__ __forceinline__ unsigned char* Vt8() const { return a.ws + WS_QX + 8 * MiB; }
    __device__ __forceinline__ bf16* WrT() const { return (bf16*)(a.ws + WS_QX + 20 * MiB); }
    __device__ __forceinline__ bf16* WxqB() const { return (bf16*)(a.ws + WS_QX + 16 * MiB); }
    __device__ __forceinline__ bf16* WinT() const { return (bf16*)(a.ws + WS_WIN); }
    __device__ __forceinline__ bf16* WoutT() const { return (bf16*)(a.ws + WS_WOUT); }
    __device__ __forceinline__ bf16* WxqT() const { return (bf16*)(a.ws + WS_WXQ); }
    __device__ __forceinline__ bf16* WxkvT() const { return (bf16*)(a.ws + WS_WXKV); }
    __device__ __forceinline__ bf16* WxoT() const { return (bf16*)(a.ws + WS_WXO); }
    __device__ __forceinline__ unsigned char* WguT8() const { return a.ws + WS_WGU; }
    __device__ __forceinline__ unsigned char* WdT8() const { return a.ws + WS_WD; }
    __device__ __forceinline__ bf16* XN() const { return (bf16*)(a.ws + WS_XN); }
    __device__ __forceinline__ bf16* MN() const { return (bf16*)(a.ws + WS_MN); }
    __device__ __forceinline__ bf16* PROJ() const { return (bf16*)(a.ws + WS_PROJ); }
    __device__ __forceinline__ bf16* YMIX() const { return (bf16*)(a.ws + WS_YMIX); }
    __device__ __forceinline__ bf16* XA() const { return (bf16*)(a.ws + WS_XA); }
    __device__ __forceinline__ unsigned char* XA8() const { return a.ws + WS_OX; }
    __device__ __forceinline__ bf16* KVX() const { return (bf16*)(a.ws + WS_KVX); }
    __device__ __forceinline__ unsigned char* PX8() const { return a.ws + WS_PX; }
    __device__ __forceinline__ bf16* XG() const { return (bf16*)(a.ws + WS_XG); }
    __device__ __forceinline__ unsigned char* ACT8() const { return a.ws + WS_ACT; }
    __device__ __forceinline__ bf16* Y() const { return (bf16*)(a.ws + WS_Y); }
    __device__ __forceinline__ float* SSP1() const { return (float*)(a.ws + WS_MISC + MS_SSP1); }
    __device__ __forceinline__ float* RGATE() const { return (float*)(a.ws + WS_MISC + MS_RGATE); }
    __device__ __forceinline__ int* TOPI() const { return (int*)(a.ws + WS_MISC + MS_TOPI); }
    __device__ __forceinline__ int* SLOT() const { return (int*)(a.ws + WS_MISC + MS_SLOT); }
    __device__ __forceinline__ int* RTOK() const { return (int*)(a.ws + WS_MISC + MS_RTOK); }
    __device__ __forceinline__ int* TEXP() const { return (int*)(a.ws + WS_MISC + MS_TEXP); }
    __device__ __forceinline__ int* NT() const { return (int*)(a.ws + WS_MISC + MS_NT); }
};

typedef float f32x2_t __attribute__((ext_vector_type(2))); typedef __bf16 bf16x2_t __attribute__((ext_vector_type(2)));
__device__ __forceinline__ unsigned cvtpk_hw(float lo, float hi) { f32x2_t v = {lo, hi}; bf16x2_t b = __builtin_convertvector(v, bf16x2_t); return __builtin_bit_cast(unsigned, b); }
struct TrItem { const float* wp; const LAS float* g; bf16* wt; int N; int k0; unsigned char* wt8; };
__device__ __forceinline__ void tr_load(const TrItem& it, int half, f32x4 (&va)[8], f32x4 (&vb)[8]) {
#pragma unroll
    for (int j = 0; j < 8; ++j) { const float* p = it.wp + (size_t)(half * 64 + 8 * j) * it.N; va[j] = __builtin_nontemporal_load((const f32x4*)p); vb[j] = __builtin_nontemporal_load((const f32x4*)(p + it.N)); }
}
__device__ __forceinline__ void tr_pack(const TrItem& it, int half, const f32x4 (&va)[8], const f32x4 (&vb)[8], LAS unsigned* T, int lane) {
    const int pr = lane >> 4, nc = lane & 15;
#pragma unroll
    for (int j = 0; j < 8; ++j) { const int pp = half * 32 + 4 * j + pr; const float ga = it.g[it.k0 + 2 * pp], gb = it.g[it.k0 + 2 * pp + 1];
        const int c = half * 8 + j;
#pragma unroll
        for (int i = 0; i < 4; ++i) T[(4 * nc + i) * 64 + ((c ^ (nc & 7)) * 4 + pr)] = cvtpk_hw(va[j][i] * ga, vb[j][i] * gb); }
}
__device__ __forceinline__ void tr_store(const TrItem& it, LAS unsigned* T, int lane) {
    LDS_WAIT(); asm volatile("" ::: "memory");
    const int pr = lane >> 4, c = lane & 15;
#pragma unroll
    for (int jj = 0; jj < 16; ++jj) { const int n = 4 * jj + pr; const v4u o = *(const LAS v4u*)(T + n * 64 + ((c ^ (jj & 7)) * 4));
        *(v4u*)(it.wt + (size_t)n * D + 8 * c) = o; }
    LDS_WAIT(); asm volatile("" ::: "memory");
}
constexpr float XASCALE = 16.f, MVSCALE = 32.f, PSCALE = 256.f;
constexpr float F8MAX = 448.f, WSCALE = 256.f, XSCALE = 16.f, ASCALE = 8.f;
__device__ __forceinline__ unsigned pk4_fp8(float a, float b, float c, float d) {
    a = __builtin_amdgcn_fmed3f(a, -F8MAX, F8MAX); b = __builtin_amdgcn_fmed3f(b, -F8MAX, F8MAX); c = __builtin_amdgcn_fmed3f(c, -F8MAX, F8MAX); d = __builtin_amdgcn_fmed3f(d, -F8MAX, F8MAX);
    int t = __builtin_amdgcn_cvt_pk_fp8_f32(a, b, 0, false); t = __builtin_amdgcn_cvt_pk_fp8_f32(c, d, t, true); return (unsigned)t; }
__device__ __forceinline__ void tr8_load(const TrItem& it, int half, f32x4 (&v)[16]) {
#pragma unroll
    for (int j = 0; j < 4; ++j)
#pragma unroll
        for (int q = 0; q < 4; ++q) v[4 * j + q] = __builtin_nontemporal_load((const f32x4*)(it.wp + (size_t)(half * 64 + 16 * j + q) * it.N));
}
template <bool NOGAIN = false>
__device__ __forceinline__ void tr8_pack(const TrItem& it, int half, const f32x4 (&v)[16], LAS unsigned* T, int lane) {
    const int pr = lane >> 4, nc = lane & 15;
#pragma unroll
    for (int j = 0; j < 4; ++j) { const LAS float* gp = it.g + it.k0 + half * 64 + 16 * j + 4 * pr;
        const float g0 = NOGAIN ? WSCALE : gp[0] * WSCALE, g1 = NOGAIN ? WSCALE : gp[1] * WSCALE, g2 = NOGAIN ? WSCALE : gp[2] * WSCALE, g3 = NOGAIN ? WSCALE : gp[3] * WSCALE; const int c = half * 4 + j;
#pragma unroll
        for (int i = 0; i < 4; ++i) T[(4 * nc + i) * 32 + ((c ^ (nc & 7)) * 4 + pr)] = pk4_fp8(v[4 * j][i] * g0, v[4 * j + 1][i] * g1, v[4 * j + 2][i] * g2, v[4 * j + 3][i] * g3); }
}
__device__ __forceinline__ void tr8_store(const TrItem& it, LAS unsigned* T, int lane) {
    LDS_WAIT(); asm volatile("" ::: "memory");
    const int rr = lane >> 3, c = lane & 7;
#pragma unroll
    for (int jj = 0; jj < 8; ++jj) { const int n = 8 * jj + rr; const v4u o = *(const LAS v4u*)(T + n * 32 + ((c ^ ((n >> 2) & 7)) * 4));
        *(v4u*)(it.wt8 + (size_t)n * D + 16 * c) = o; }
    LDS_WAIT(); asm volatile("" ::: "memory");
}
template <int NR>
__device__ __forceinline__ void rms_rows_to_bf16(const float* xrow, const float* g, bf16* orow, int lane) {
    f32x4 v[NR][4];
#pragma unroll
    for (int r = 0; r < NR; ++r)
#pragma unroll
        for (int j = 0; j < 4; ++j) v[r][j] = __builtin_nontemporal_load((const f32x4*)(xrow + (size_t)r * D) + lane + 64 * j);
    const f32x4* gr = (const f32x4*)g + lane;
#pragma unroll
    for (int r = 0; r < NR; ++r) { float s = 0.f;
#pragma unroll
        for (int j = 0; j < 4; ++j) s += (v[r][j].x * v[r][j].x + v[r][j].y * v[r][j].y) + (v[r][j].z * v[r][j].z + v[r][j].w * v[r][j].w);
        const float rstd = 1.f / sqrtf(wave_sum(s) * (1.f / D) + EPS);
        unsigned long long* o8 = (unsigned long long*)(orow + (size_t)r * D) + lane;
#pragma unroll
        for (int j = 0; j < 4; ++j) { const f32x4 gg = gr[64 * j];
            o8[64 * j] = (unsigned long long)pk2(v[r][j].x * rstd * gg.x, v[r][j].y * rstd * gg.y) | ((unsigned long long)pk2(v[r][j].z * rstd * gg.z, v[r][j].w * rstd * gg.w) << 32); } }
}
template <int NA, int NB>
__device__ __forceinline__ void rms_rows2_to_bf16(const float* xa, const float* ga, bf16* oa, const float* xb, const float* gb, bf16* ob, int lane) {
    f32x4 v[NA + NB][4];
#pragma unroll
    for (int r = 0; r < NA + NB; ++r)
#pragma unroll
        for (int j = 0; j < 4; ++j) v[r][j] = __builtin_nontemporal_load((const f32x4*)((r < NA ? xa + (size_t)r * D : xb + (size_t)(r - NA) * D)) + lane + 64 * j);
#pragma unroll
    for (int r = 0; r < NA + NB; ++r) { float s = 0.f; const f32x4* gr = (const f32x4*)(r < NA ? ga : gb) + lane;
#pragma unroll
        for (int j = 0; j < 4; ++j) s += (v[r][j].x * v[r][j].x + v[r][j].y * v[r][j].y) + (v[r][j].z * v[r][j].z + v[r][j].w * v[r][j].w);
        const float rstd = 1.f / sqrtf(wave_sum(s) * (1.f / D) + EPS);
        unsigned long long* o8 = (unsigned long long*)(r < NA ? oa + (size_t)r * D : ob + (size_t)(r - NA) * D) + lane;
#pragma unroll
        for (int j = 0; j < 4; ++j) { const f32x4 gg = gr[64 * j];
            o8[64 * j] = (unsigned long long)pk2(v[r][j].x * rstd * gg.x, v[r][j].y * rstd * gg.y) | ((unsigned long long)pk2(v[r][j].z * rstd * gg.z, v[r][j].w * rstd * gg.w) << 32); } }
}
constexpr int I_IN = 8 * 48, I_SQ = 8 * 16, I_KV = 8 * 32, I_GU1 = 8 * 32, I_GU = NE * I_GU1, I_D1 = 8 * 16, I_DN = NE * I_D1;
constexpr int I_MOE = I_GU + I_DN, NITEMS = I_MOE + I_IN + 3 * I_SQ + I_KV;
static_assert(I_MOE == 12288 && NITEMS - I_MOE == 1024, "work split assumes 2048 waves: one non-expert item for waves < 1024 in the prologue");
constexpr int I_P1 = 96 * NWAVES * 14;
constexpr int GT_OFF = 132096;
__device__ __forceinline__ void tr_tables(Frame& F) {
    LAS float* gt = (LAS float*)(F.lds + GT_OFF);
    for (int k = F.tid; k < D; k += NWAVES * 64) { gt[k] = 1.f; gt[D + k] = F.g_ffn()[k]; gt[2 * D + k] = F.g_xattn()[k]; }
    __syncthreads();
}
template <bool F8>
__device__ __forceinline__ TrItem tr_decode(Frame& F, int item) {
    int r = item; const float* W; bf16* WT = nullptr; unsigned char* WT8 = nullptr; int gsel = 0; int N = D;
    if (r < I_GU) { const int e = r / I_GU1; W = F.w_gu() + (size_t)e * D * NGU; WT8 = F.WguT8() + (size_t)e * NGU * D; gsel = 1; N = NGU; r %= I_GU1; }
    else if ((r -= I_GU) < I_DN) { const int e = r / I_D1; W = F.w_down() + (size_t)e * D * D; WT8 = F.WdT8() + (size_t)e * D * D; r %= I_D1; }
    else if ((r -= I_DN) < I_IN) { W = F.w_in(); WT = F.WinT(); N = NPROJ; }
    else if ((r -= I_IN) < I_SQ) { W = F.w_out(); WT = F.WoutT(); }
    else if ((r -= I_SQ) < I_SQ) { W = F.w_xq(); WT = F.WxqT(); gsel = 2; }
    else if ((r -= I_SQ) < I_KV) { W = F.w_xkv(); WT = F.WxkvT(); N = 2 * D; }
    else { r -= I_KV; W = F.w_xo(); WT = F.WxoT(); }
    const int nblk = N / 64, kb = r / nblk, nb = r % nblk, k0 = 128 * kb, n0 = 64 * nb;
    TrItem t; t.N = N; t.k0 = k0; t.g = (const LAS float*)(F.lds + GT_OFF) + gsel * D; t.wp = W + (size_t)(k0 + (F8 ? 4 : 2) * (F.lane >> 4)) * N + n0 + 4 * (F.lane & 15);
    t.wt = F8 ? nullptr : WT + (size_t)n0 * D + k0; t.wt8 = F8 ? WT8 + (size_t)n0 * D + k0 : nullptr; return t;
}
template <bool F8, bool NOGAIN = false>
__device__ __forceinline__ void tr_run(Frame& F, int first, int stride, int last, LAS unsigned* scr) {
    if (first >= last) return;
    int item = first; TrItem cur = tr_decode<F8>(F, item), nxt = cur;
    if constexpr (F8) {
        f32x4 v0[16], v1[16]; TrItem prev = cur; int par = 0;
        auto LD1 = [&]() { tr8_load(cur, 1, v1); };
        auto ST = [&]() { tr8_store(prev, scr + (par ^ 1) * 2048, F.lane); };
        auto PK0 = [&]() { tr8_pack<NOGAIN>(cur, 0, v0, scr + par * 2048, F.lane); };
        auto PK1 = [&]() { tr8_pack<NOGAIN>(cur, 1, v1, scr + par * 2048, F.lane); };
        auto NX = [&]() { nxt = tr_decode<F8>(F, item + stride); tr8_load(nxt, 0, v0); };
        auto ADV = [&]() { prev = cur; cur = nxt; item += stride; par ^= 1; };
        tr8_load(cur, 0, v0);
        if (item + stride < last) {
            LD1(); PK0(); NX(); PK1(); ADV();
            while (item + stride < last) { LD1(); ST(); PK0(); NX(); PK1(); ADV(); }
            LD1(); ST(); PK0(); PK1(); prev = cur; par ^= 1; ST();
        } else { LD1(); PK0(); PK1(); prev = cur; par ^= 1; ST(); }
    } else {
        f32x4 a0[8], b0[8], a1[8], b1[8];
        tr_load(cur, 0, a0, b0);
        for (;;) {
            tr_load(cur, 1, a1, b1);
            tr_pack(cur, 0, a0, b0, scr, F.lane);
            const bool has_next = item + stride < last;
            if (has_next) { nxt = tr_decode<F8>(F, item + stride); tr_load(nxt, 0, a0, b0); }
            tr_pack(cur, 1, a1, b1, scr, F.lane);
            tr_store(cur, scr, F.lane);
            if (!has_next) break;
            cur = nxt; item += stride;
        }
    }
}
__device__ __forceinline__ void p0_prologue(Frame& F) {
    LAS unsigned* scr = (LAS unsigned*)(F.lds + F.wave * 16384);
    const int gw = F.vcu * NWAVES + F.wave, NGW = F.G * NWAVES;
    tr_tables(F);
    tr_run<false>(F, I_MOE + gw, NGW, NITEMS, scr);
    if (NGW == 2048) {
        if (gw < 1024) rms_rows2_to_bf16<4, 1>(F.x() + (size_t)(gw * 4) * D, F.g_mix(), F.XN() + (size_t)(gw * 4) * D, F.mem() + (size_t)gw * D, F.g_mem(), F.MN() + (size_t)gw * D, F.lane);
        else { const int m0 = 4096 + (gw - 1024) * 12;
#pragma unroll 1
               for (int j = 0; j < 2; ++j) rms_rows_to_bf16<6>(F.x() + (size_t)(m0 + 6 * j) * D, F.g_mix(), F.XN() + (size_t)(m0 + 6 * j) * D, F.lane); }
        if (gw >= NGW - 64) { const int n = (gw - (NGW - 64)) & 31, part = (gw - (NGW - 64)) >> 5;
            for (int i = 0; i < 8; ++i) { const int k = part * 512 + F.lane + 64 * i; const float v = F.g_ffn()[k] * F.w_router()[(size_t)k * NE + n];
                const unsigned hi = f2bf(v); const float rem = v - bf2f(hi); F.WrT()[(size_t)n * D + k] = (bf16)hi; F.WrT()[(size_t)(32 + n) * D + k] = (bf16)f2bf(rem); } }
        if (gw >= 1024) { const int c = gw - 1024; const float gc = F.g_xattn()[c];
            const f32x4* wr = (const f32x4*)(F.w_xq() + (size_t)c * D) + F.lane; unsigned long long* o8 = (unsigned long long*)(F.WxqB() + (size_t)c * D) + F.lane;
#pragma unroll
            for (int j = 0; j < 4; ++j) { const f32x4 v = wr[64 * j] * gc; o8[64 * j] = (unsigned long long)pk2(v.x, v.y) | ((unsigned long long)pk2(v.z, v.w) << 32); } }
    } else {
        for (int m = gw * 4; m < NTOK; m += NGW * 4) rms_rows_to_bf16<4>(F.x() + (size_t)m * D, F.g_mix(), F.XN() + (size_t)m * D, F.lane);
        for (int m = gw; m < NMEM; m += NGW) rms_rows_to_bf16<1>(F.mem() + (size_t)m * D, F.g_mem(), F.MN() + (size_t)m * D, F.lane);
    }
}

namespace pg8 {
typedef short bf16x8 __attribute__((ext_vector_type(8)));
constexpr int BM = 256, BK = 64, HALF = 128, HTB = HALF * BK * 2, STAGE_BYTES = 8 * HTB, NXCD = 8, WGM = 8;
__host__ __device__ __forceinline__ int lds_byte(int r, int c) { const int st = (r >> 4) * 2 + (c >> 5), rr = r & 15, cc = c & 31, ob = rr * 64 + cc * 2; return st * 1024 + (ob ^ (((ob >> 9) & 1) << 5)); }
__host__ __device__ __forceinline__ void stage_rc(int b, int& R, int& C) { const int st = b / 1024, sb = b % 1024, swz = sb ^ (((sb >> 9) & 1) << 5); R = (st >> 1) * 16 + swz / 64; C = (st & 1) * 32 + (swz % 64) / 2; }
__host__ __device__ __forceinline__ int perm16(int R) { return 64 * (R >> 5) + 16 * ((R >> 2) & 3) + 4 * ((R >> 4) & 1) + (R & 3); }
__host__ __device__ __forceinline__ int perm32(int rho) { const int n = rho >> 4, i = rho & 15; return 8 * (i >> 2) + 4 * n + (i & 3); }
struct Unit { int pm, pn, aux; long a_off, b_off; };
struct Gemm { const bf16* A; const bf16* Bt; int lda, ldb, K; const LAS int* gl; };
struct StaticOrder {
    int nM, nN, nwg, G, c, lda, ldb, wgm; const LAS int* texp;
    __device__ void init(int nM_, int nN_, int G_, int c_, int lda_, int ldb_, const LAS int* texp_, int wgm_ = WGM) { nM = nM_; nN = nN_; nwg = nM * nN; G = G_; c = c_; lda = lda_; ldb = ldb_; texp = texp_; wgm = wgm_; }
    __device__ bool next(int i, Unit& u) const {
        const long L = (long)i * G + c; if (L >= nwg) return false;
        int wgid = (int)L; { const int q = nwg / NXCD, r = nwg % NXCD, xcd = wgid % NXCD, off = wgid / NXCD; wgid = (xcd < r ? xcd * (q + 1) : r * (q + 1) + (xcd - r) * q) + off; }
        const int nig = wgm * nN, gid = wgid / nig, fm = gid * wgm, gsz = (nM - fm) < wgm ? (nM - fm) : wgm;
        u.pm = fm + ((wgid % nig) % gsz); u.pn = (wgid % nig) / gsz;
        u.aux = texp ? texp[u.pm] : 0;
        u.a_off = (long)u.pm * BM * lda; u.b_off = ((long)u.aux * nN + u.pn) * BM * ldb; return true;
    }
};
struct OneUnit { Unit u0; __device__ bool next(int i, Unit& u) const { if (i > 0) return false; u = u0; return true; } };

__device__ __forceinline__ unsigned cvt_pk_bf16(float lo, float hi) { unsigned r; asm volatile("v_cvt_pk_bf16_f32 %0, %1, %2" : "=v"(r) : "v"(lo), "v"(hi)); return r; }

typedef int v8i_t __attribute__((ext_vector_type(8))); typedef int v4i_t __attribute__((ext_vector_type(4)));
__device__ __forceinline__ f32x4 mma_fp8(bf16x8 b0, bf16x8 b1, bf16x8 a0, bf16x8 a1, f32x4 c) {
    const v4i_t x0 = __builtin_bit_cast(v4i_t, b0), x1 = __builtin_bit_cast(v4i_t, b1), y0 = __builtin_bit_cast(v4i_t, a0), y1 = __builtin_bit_cast(v4i_t, a1);
    const v8i_t X = __builtin_shufflevector(x0, x1, 0, 1, 2, 3, 4, 5, 6, 7), Y = __builtin_shufflevector(y0, y1, 0, 1, 2, 3, 4, 5, 6, 7);
    asm volatile("v_mfma_f32_16x16x128_f8f6f4 %0, %1, %2, %0" : "+v"(c) : "v"(X), "v"(Y));
    return c; }
#define MMA_FP8_DRAIN() asm volatile("s_nop 15\n\ts_nop 15" ::: "memory")
template <class Epi, class Sched, bool ALIGN_EPI, bool F8 = false>
__device__ __forceinline__ void gemm_phase(LAS unsigned char* lds, const Gemm g, const Sched& S, const Epi& E) {
    const int tid = threadIdx.x, wid = __builtin_amdgcn_readfirstlane(tid >> 6), lane = tid & 63, wr = wid >> 2, wc = wid & 3, fr = lane & 15, fq = lane >> 4;
    const int K = g.K, nt = K / BK;
    unsigned voffB[2]; int RA[2], CA[2];
#pragma unroll
    for (int i = 0; i < 2; ++i) { int R, C; stage_rc(tid * 16 + i * 8192, R, C); const int Rb = Epi::PERM16 ? perm16(R) : Epi::PERM ? ((R & ~31) + perm32(R & 31)) : R;
        RA[i] = R; CA[i] = C; voffB[i] = (unsigned)(Rb * g.ldb + C) * 2u; }
#define PG8_AOFF(vo, ui_) do { _Pragma("unroll") for (int h_ = 0; h_ < 2; ++h_) _Pragma("unroll") for (int i_ = 0; i_ < 2; ++i_) { \
        const int row_ = g.gl ? g.gl[(ui_) * BM + h_ * HALF + RA[i_]] : (h_ * HALF + RA[i_]); vo[h_][i_] = (unsigned)(row_ * g.lda + CA[i_]) * 2u; } } while (0)
    const size_t kstep = (size_t)(BK * 2);
    const size_t hstepB = (size_t)(Epi::PERM16 ? 8 : HALF) * g.ldb * 2;
    const unsigned ldsw = (unsigned)wid * 1024u;
    const int aoff = lds_byte(wr * 64 + fr, fq * 8), boff = lds_byte(wc * 32 + fr, fq * 8);
#define PG8_SA(b, h) (((b) * 2 + (h)) * HTB)
#define PG8_SB(b, h) ((4 + (b) * 2 + (h)) * HTB)
#define PG8_STAGE(bufoff, gbase, voff) do { _Pragma("unroll") for (int _i = 0; _i < 2; ++_i) { unsigned vo_ = (voff)[_i]; if constexpr (F8) asm volatile("" : "+v"(vo_));     \
        __builtin_amdgcn_global_load_lds((const unsigned*)((const char*)(gbase) + vo_), (LAS unsigned*)(lds + (bufoff) + ldsw + _i * 8192), 16, 0, 0); } } while (0)
#define PG8_LDA(dst, b, h) do { _Pragma("unroll") for (int m = 0; m < 4; ++m) _Pragma("unroll") for (int k = 0; k < 2; ++k) dst[m][k] = *(const LAS bf16x8*)(lds + PG8_SA(b, h) + aoff + m * 2048 + k * 1024); } while (0)
#define PG8_LDB(dst, b, h) do { _Pragma("unroll") for (int n = 0; n < 2; ++n) _Pragma("unroll") for (int k = 0; k < 2; ++k) dst[n][k] = *(const LAS bf16x8*)(lds + PG8_SB(b, h) + boff + n * 2048 + k * 1024); } while (0)
#define PG8_MMA(ai, bj, At, Bt) do { __builtin_amdgcn_s_setprio(1); _Pragma("unroll") for (int m = 0; m < 4; ++m) _Pragma("unroll") for (int n = 0; n < 2; ++n) { \
        if constexpr (F8) acc[ai][bj][m][n] = mma_fp8(Bt[n][0], Bt[n][1], At[m][0], At[m][1], acc[ai][bj][m][n]); \
        else { _Pragma("unroll") for (int k = 0; k < 2; ++k) acc[ai][bj][m][n] = __builtin_amdgcn_mfma_f32_16x16x32_bf16(Bt[n][k], At[m][k], acc[ai][bj][m][n], 0, 0, 0); } } \
        __builtin_amdgcn_s_setprio(0); } while (0)
#define PG8_WAIT_V(n) asm volatile("s_waitcnt vmcnt(" #n ")" ::: "memory")
#define PG8_WAIT_L(n) asm volatile("s_waitcnt lgkmcnt(" #n ")" ::: "memory")
#define PG8_BAR __builtin_amdgcn_s_barrier()
#define PG8_SCHED __builtin_amdgcn_sched_barrier(0)
    Unit cur, nxt; int ui = 0;
    if (!S.next(0, cur)) return;
    f32x4 acc[2][2][4][2];
#pragma unroll
    for (int a = 0; a < 2; ++a)
#pragma unroll
        for (int b = 0; b < 2; ++b)
#pragma unroll
            for (int m = 0; m < 4; ++m)
#pragma unroll
                for (int n = 0; n < 2; ++n) acc[a][b][m][n] = (f32x4){0.f, 0.f, 0.f, 0.f};
    bf16x8 At[4][2], B0[2][2], B1[2][2];
    const char* cA = (const char*)(g.A + (g.gl ? 0 : cur.a_off)); const char* cB = (const char*)(g.Bt + cur.b_off);
    unsigned vAc[2][2], vAn[2][2];
    PG8_AOFF(vAc, 0);
    PG8_STAGE(PG8_SB(0, 0), cB, voffB); PG8_STAGE(PG8_SB(0, 1), cB + hstepB, voffB); PG8_STAGE(PG8_SA(0, 0), cA, vAc[0]); PG8_STAGE(PG8_SA(0, 1), cA, vAc[1]);
    if (wr == 1) PG8_BAR;
    PG8_WAIT_V(2); PG8_BAR;
    PG8_STAGE(PG8_SB(1, 0), cB + kstep, voffB); PG8_STAGE(PG8_SA(1, 0), cA + kstep, vAc[0]); PG8_STAGE(PG8_SB(1, 1), cB + hstepB + kstep, voffB);
    PG8_WAIT_V(6); PG8_BAR;
    for (;;) {
        const bool has_next = S.next(ui + 1, nxt);
        const char* nA = has_next ? (const char*)(g.A + (g.gl ? 0 : nxt.a_off)) : cA; const char* nB = has_next ? (const char*)(g.Bt + nxt.b_off) : cB;
        if (has_next) PG8_AOFF(vAn, ui + 1); else {
#pragma unroll
            for (int h_ = 0; h_ < 2; ++h_)
#pragma unroll
                for (int i_ = 0; i_ < 2; ++i_) vAn[h_][i_] = vAc[h_][i_]; }
#pragma unroll 1
        for (int t = 0; t < nt; t += 2) {
            const bool last = (t == nt - 2);
            const char* a1 = cA + (size_t)(t + 1) * kstep;
            const char* a2 = last ? nA : cA + (size_t)(t + 2) * kstep; const char* b2 = last ? nB : cB + (size_t)(t + 2) * kstep;
            const char* a3 = a2 + kstep; const char* b3 = b2 + kstep;
            unsigned v2[2][2];
#pragma unroll
            for (int h_ = 0; h_ < 2; ++h_)
#pragma unroll
                for (int i_ = 0; i_ < 2; ++i_) v2[h_][i_] = last ? vAn[h_][i_] : vAc[h_][i_];
            PG8_LDB(B0, 0, 0); PG8_LDB(B1, 0, 1); PG8_SCHED; PG8_LDA(At, 0, 0); PG8_STAGE(PG8_SA(1, 1), a1, vAc[1]);
            PG8_WAIT_V(8); PG8_WAIT_L(0); PG8_BAR; PG8_MMA(0, 0, At, B0); PG8_MMA(0, 1, At, B1); PG8_BAR; PG8_SCHED;
            PG8_LDA(At, 0, 1); PG8_STAGE(PG8_SB(0, 0), b2, voffB); PG8_STAGE(PG8_SB(0, 1), b2 + hstepB, voffB); PG8_STAGE(PG8_SA(0, 0), a2, v2[0]);
            PG8_WAIT_V(8); PG8_WAIT_L(0); PG8_BAR; PG8_MMA(1, 0, At, B0); PG8_MMA(1, 1, At, B1); PG8_BAR; PG8_SCHED;
            PG8_LDB(B0, 1, 0); PG8_LDB(B1, 1, 1); PG8_SCHED; PG8_LDA(At, 1, 0); PG8_STAGE(PG8_SA(0, 1), a2, v2[1]);
            PG8_WAIT_V(8); PG8_WAIT_L(0); PG8_BAR; PG8_MMA(0, 0, At, B0); PG8_MMA(0, 1, At, B1); PG8_BAR; PG8_SCHED;
            PG8_LDA(At, 1, 1); PG8_STAGE(PG8_SB(1, 0), b3, voffB); PG8_STAGE(PG8_SB(1, 1), b3 + hstepB, voffB); PG8_STAGE(PG8_SA(1, 0), a3, v2[0]);
            PG8_WAIT_V(8); PG8_WAIT_L(0); PG8_BAR; PG8_MMA(1, 0, At, B0); PG8_MMA(1, 1, At, B1); PG8_BAR; PG8_SCHED;
        }
        if constexpr (F8) MMA_FP8_DRAIN();
        if constexpr (ALIGN_EPI) { if (wr == 0) PG8_BAR; }
        if constexpr (!Epi::AFTER_DRAIN) { E(acc, cur, wr, wc, fr, fq); }
        if (!has_next) break;
#pragma unroll
        for (int a = 0; a < 2; ++a)
#pragma unroll
            for (int b = 0; b < 2; ++b)
#pragma unroll
                for (int m = 0; m < 4; ++m)
#pragma unroll
                    for (int n = 0; n < 2; ++n) acc[a][b][m][n] = (f32x4){0.f, 0.f, 0.f, 0.f};
        cur = nxt; cA = nA; cB = nB; ++ui;
#pragma unroll
        for (int h_ = 0; h_ < 2; ++h_)
#pragma unroll
            for (int i_ = 0; i_ < 2; ++i_) vAc[h_][i_] = vAn[h_][i_];
        if constexpr (ALIGN_EPI) { if (wr == 1) PG8_BAR; }
    }
    PG8_WAIT_V(0);
    if constexpr (!ALIGN_EPI) { if (wr == 0) PG8_BAR; }
    PG8_BAR;
    if constexpr (Epi::AFTER_DRAIN) { E.fused(acc, cur, wr, wc, fr, fq, lds, wid, lane); }
#undef PG8_AOFF
#undef PG8_SA
#undef PG8_SB
#undef PG8_STAGE
#undef PG8_LDA
#undef PG8_LDB
#undef PG8_MMA
#undef PG8_WAIT_V
#undef PG8_WAIT_L
#undef PG8_BAR
#undef PG8_SCHED
}

typedef float f32x2 __attribute__((ext_vector_type(2)));
#define EPI_LOOP_AI_M _Pragma("unroll") for (int ai = 0; ai < 2; ++ai) _Pragma("unroll") for (int m = 0; m < 4; ++m)
struct EpiBf16 {
    static constexpr bool PERM = true, AFTER_DRAIN = false, PERM16 = false;
    bf16* O; int ldc; int pn_lo, pn_hi; float scale;
    __device__ __forceinline__ void operator()(const f32x4 (&acc)[2][2][4][2], const Unit& u, int wr, int wc, int fr, int fq) const {
        const float sc = (u.pn >= pn_lo && u.pn < pn_hi) ? scale : 1.f;
        const int row0 = u.pm * BM + wr * 64 + fr, col0 = u.pn * BM + wc * 32 + 8 * fq;
        EPI_LOOP_AI_M { bf16* rowp = O + (size_t)(row0 + ai * HALF + m * 16) * ldc + col0;
#pragma unroll
            for (int bj = 0; bj < 2; ++bj) { const f32x4 v0 = acc[ai][bj][m][0] * sc, v1 = acc[ai][bj][m][1] * sc;
                v4u w; w.x = cvt_pk_bf16(v0[0], v0[1]); w.y = cvt_pk_bf16(v0[2], v0[3]); w.z = cvt_pk_bf16(v1[0], v1[1]); w.w = cvt_pk_bf16(v1[2], v1[3]);
                *(v4u*)(rowp + bj * HALF) = w; } }
    }
};
struct EpiKV {
    static constexpr bool PERM = true, AFTER_DRAIN = false, PERM16 = false;
    bf16* O;
    __device__ __forceinline__ void operator()(const f32x4 (&acc)[2][2][4][2], const Unit& u, int wr, int wc, int fr, int fq) const {
        const int row0 = u.pm * BM + wr * 64 + fr, col0 = u.pn * BM + wc * 32 + 8 * fq;
        EPI_LOOP_AI_M { bf16* rowp = O + (size_t)(row0 + ai * HALF + m * 16) * (2 * D) + col0;
#pragma unroll
            for (int bj = 0; bj < 2; ++bj) { const f32x4 v0 = acc[ai][bj][m][0], v1 = acc[ai][bj][m][1];
                v4u w; w.x = cvt_pk_bf16(v0[0], v0[1]); w.y = cvt_pk_bf16(v0[2], v0[3]); w.z = cvt_pk_bf16(v1[0], v1[1]); w.w = cvt_pk_bf16(v1[2], v1[3]);
                *(v4u*)(rowp + bj * HALF) = w; } }
    }
};
struct EpiF8 {
    static constexpr bool PERM = true, AFTER_DRAIN = false, PERM16 = false;
    unsigned char* O; int ldc; float scale;
    __device__ __forceinline__ void operator()(const f32x4 (&acc)[2][2][4][2], const Unit& u, int wr, int wc, int fr, int fq) const {
        const int row0 = u.pm * BM + wr * 64 + fr, col0 = u.pn * BM + wc * 32 + 8 * fq;
        EPI_LOOP_AI_M { unsigned char* rowp = O + (size_t)(row0 + ai * HALF + m * 16) * ldc + col0;
#pragma unroll
            for (int bj = 0; bj < 2; ++bj) { const f32x4 v0 = acc[ai][bj][m][0] * scale, v1 = acc[ai][bj][m][1] * scale;
                v2u w; w.x = pk4_fp8(v0[0], v0[1], v0[2], v0[3]); w.y = pk4_fp8(v1[0], v1[1], v1[2], v1[3]); *(v2u*)(rowp + bj * HALF) = w; } }
    }
};
struct EpiResIn {
    static constexpr bool PERM = true, AFTER_DRAIN = false, PERM16 = false;
    const float* X; bf16* XA; float* ssp; unsigned char* XA8;
    __device__ __forceinline__ void operator()(const f32x4 (&acc)[2][2][4][2], const Unit& u, int wr, int wc, int fr, int fq) const {
        const int row0 = u.pm * BM + wr * 64 + fr, col0 = u.pn * BM + wc * 32 + 8 * fq;
        EPI_LOOP_AI_M { const int r = row0 + ai * HALF + m * 16; const size_t off = (size_t)r * D + col0; float s = 0.f;
#pragma unroll
            for (int bj = 0; bj < 2; ++bj) { const f32x4 o0 = __builtin_nontemporal_load((const f32x4*)(X + off + bj * HALF)) + acc[ai][bj][m][0], o1 = __builtin_nontemporal_load((const f32x4*)(X + off + bj * HALF + 4)) + acc[ai][bj][m][1];
                s += ((o0[0] * o0[0] + o0[1] * o0[1]) + (o0[2] * o0[2] + o0[3] * o0[3])) + ((o1[0] * o1[0] + o1[1] * o1[1]) + (o1[2] * o1[2] + o1[3] * o1[3]));
                v4u w; w.x = cvt_pk_bf16(o0[0], o0[1]); w.y = cvt_pk_bf16(o0[2], o0[3]); w.z = cvt_pk_bf16(o1[0], o1[1]); w.w = cvt_pk_bf16(o1[2], o1[3]);
                *(v4u*)(XA + off + bj * HALF) = w;
                v2u w8; w8.x = pk4_fp8(o0[0] * XASCALE, o0[1] * XASCALE, o0[2] * XASCALE, o0[3] * XASCALE); w8.y = pk4_fp8(o1[0] * XASCALE, o1[1] * XASCALE, o1[2] * XASCALE, o1[3] * XASCALE);
                *(v2u*)(XA8 + off + bj * HALF) = w8; }
            s += __shfl_xor(s, 16); s += __shfl_xor(s, 32); if (fq == 0) ssp[(size_t)r * 16 + u.pn * 4 + wc] = s;
            if (m & 1) asm volatile("" ::: "memory"); }
    }
};
struct EpiResB {
    static constexpr bool PERM = true, AFTER_DRAIN = false, PERM16 = false;
    const bf16* Xb; bf16* O; float inv;
    __device__ __forceinline__ void operator()(const f32x4 (&acc)[2][2][4][2], const Unit& u, int wr, int wc, int fr, int fq) const {
        const int row0 = u.pm * BM + wr * 64 + fr, col0 = u.pn * BM + wc * 32 + 8 * fq;
        EPI_LOOP_AI_M { const size_t off = (size_t)(row0 + ai * HALF + m * 16) * D + col0;
#pragma unroll
            for (int bj = 0; bj < 2; ++bj) { const v4u xb = *(const v4u*)(Xb + off + bj * HALF);
                const f32x4 a0 = acc[ai][bj][m][0] * inv, a1 = acc[ai][bj][m][1] * inv;
                v4u w; w.x = cvt_pk_bf16(bf2f(xb.x & 0xffffu) + a0[0], bf2f(xb.x >> 16) + a0[1]); w.y = cvt_pk_bf16(bf2f(xb.y & 0xffffu) + a0[2], bf2f(xb.y >> 16) + a0[3]);
                w.z = cvt_pk_bf16(bf2f(xb.z & 0xffffu) + a1[0], bf2f(xb.z >> 16) + a1[1]); w.w = cvt_pk_bf16(bf2f(xb.w & 0xffffu) + a1[2], bf2f(xb.w >> 16) + a1[3]);
                *(v4u*)(O + off + bj * HALF) = w; }
            if (m & 1) asm volatile("" ::: "memory"); }
    }
};
struct EpiGU {
    static constexpr bool PERM = true, AFTER_DRAIN = false, PERM16 = true;
    unsigned char* O; const float* bias;
    __device__ __forceinline__ void operator()(const f32x4 (&acc)[2][2][4][2], const Unit& u, int wr, int wc, int fr, int fq) const {
        const int row0 = u.pm * BM + wr * 64 + fr, col0 = u.pn * BM + wc * 64 + 16 * fq;
        constexpr float inv = 1.f / (XSCALE * WSCALE);
        f32x4 bv[2][2];
#pragma unroll
        for (int bj = 0; bj < 2; ++bj)
#pragma unroll
            for (int n = 0; n < 2; ++n) bv[bj][n] = *(const f32x4*)(bias + (size_t)u.aux * NGU + col0 + 8 * bj + 4 * n);
        EPI_LOOP_AI_M { unsigned char* rowp = O + (size_t)(row0 + ai * HALF + m * 16) * D + (col0 >> 1);
            v2u w;
#pragma unroll
            for (int bj = 0; bj < 2; ++bj) { const f32x4 v0 = acc[ai][bj][m][0] * inv + bv[bj][0], v1 = acc[ai][bj][m][1] * inv + bv[bj][1];
                float o[4];
#pragma unroll
                for (int j = 0; j < 4; ++j) { float gg = (j < 2) ? v0[2 * j] : v1[2 * j - 4], uu = (j < 2) ? v0[2 * j + 1] : v1[2 * j - 3];
                    gg = fminf(gg, 7.f); uu = fminf(fmaxf(uu, -7.f), 7.f);
                    const float glu = gg * __builtin_amdgcn_rcpf(1.f + __builtin_amdgcn_exp2f(-1.702f * 1.4426950408889634f * gg)); o[j] = __builtin_fmaf(uu, ASCALE, ASCALE) * glu; }
                int t = __builtin_amdgcn_cvt_pk_fp8_f32(o[0], o[1], 0, false); t = __builtin_amdgcn_cvt_pk_fp8_f32(o[2], o[3], t, true); if (bj == 0) w.x = (unsigned)t; else w.y = (unsigned)t; }
            *(v2u*)rowp = w; }
    }
};
constexpr float Y8SCALE = 8.f, Y8MAX = 440.f;
struct EpiDown {
    static constexpr bool PERM = true, AFTER_DRAIN = false, PERM16 = true;
    unsigned char* O; const float* bias; const float* rgate;
    __device__ __forceinline__ void operator()(const f32x4 (&acc)[2][2][4][2], const Unit& u, int wr, int wc, int fr, int fq) const {
        const int row0 = u.pm * BM + wr * 64 + fr, col0 = u.pn * BM + wc * 64 + 16 * fq;
        f32x4 bv[2][2];
#pragma unroll
        for (int bj = 0; bj < 2; ++bj)
#pragma unroll
            for (int n = 0; n < 2; ++n) bv[bj][n] = *(const f32x4*)(bias + (size_t)u.aux * D + col0 + 8 * bj + 4 * n);
        constexpr float inv = 1.f / (ASCALE * WSCALE);
        EPI_LOOP_AI_M { const int r = row0 + ai * HALF + m * 16; const float gs = rgate[r] * Y8SCALE; unsigned char* rowp = O + (size_t)r * D + col0;
            v4u w;
#pragma unroll
            for (int bj = 0; bj < 2; ++bj) { f32x4 v0 = (acc[ai][bj][m][0] * inv + bv[bj][0]) * gs, v1 = (acc[ai][bj][m][1] * inv + bv[bj][1]) * gs;
#pragma unroll
                for (int j = 0; j < 4; ++j) { v0[j] = __builtin_amdgcn_fmed3f(v0[j], -Y8MAX, Y8MAX); v1[j] = __builtin_amdgcn_fmed3f(v1[j], -Y8MAX, Y8MAX); }
                int t = __builtin_amdgcn_cvt_pk_fp8_f32(v0[0], v0[1], 0, false); t = __builtin_amdgcn_cvt_pk_fp8_f32(v0[2], v0[3], t, true); const unsigned a = (unsigned)t;
                t = __builtin_amdgcn_cvt_pk_fp8_f32(v1[0], v1[1], 0, false); t = __builtin_amdgcn_cvt_pk_fp8_f32(v1[2], v1[3], t, true);
                if (bj == 0) { w.x = a; w.y = (unsigned)t; } else { w.z = a; w.w = (unsigned)t; } }
            *(v4u*)rowp = w; }
    }
};
struct EpiSoftmax {
    static constexpr bool PERM = true, AFTER_DRAIN = true, PERM16 = false;
    unsigned char* O; int ldc; const float* ssp;
    __device__ __forceinline__ void fused(f32x4 (&acc)[2][2][4][2], const Unit& u, int wr, int wc, int fr, int fq, LAS unsigned char* lds, int wid, int lane) const {
        LAS f32x2* T = (LAS f32x2*)lds;
        EPI_LOOP_AI_M { const int row = ai * HALF + wr * 64 + m * 16 + fr;
            const f32x4 p = *(const f32x4*)(ssp + (size_t)(u.pm * BM + row) * 16 + 4 * fq);
            float sq = (p[0] + p[1]) + (p[2] + p[3]); sq += __shfl_xor(sq, 16); sq += __shfl_xor(sq, 32);
            const float sc = (QXSCALE / (XASCALE * MVSCALE)) / sqrtf(sq * (1.f / D) + EPS);
            float mx = -INFINITY;
#pragma unroll
            for (int bj = 0; bj < 2; ++bj)
#pragma unroll
                for (int n = 0; n < 2; ++n) { const f32x4 x = acc[ai][bj][m][n] * sc; acc[ai][bj][m][n] = x; mx = fmaxf(mx, fmaxf(fmaxf(x[0], x[1]), fmaxf(x[2], x[3]))); }
            mx = fmaxf(mx, __shfl_xor(mx, 16)); mx = fmaxf(mx, __shfl_xor(mx, 32));
            float s = 0.f;
#pragma unroll
            for (int bj = 0; bj < 2; ++bj)
#pragma unroll
                for (int n = 0; n < 2; ++n) { f32x4 x = acc[ai][bj][m][n];
#pragma unroll
                    for (int j = 0; j < 4; ++j) { x[j] = __builtin_amdgcn_exp2f(x[j] - mx); s += x[j]; }
                    acc[ai][bj][m][n] = x; }
            s += __shfl_xor(s, 16); s += __shfl_xor(s, 32);
            if (fq == 0) T[row * 4 + wc] = (f32x2){mx, s};
            __builtin_amdgcn_sched_barrier(0); }
        asm volatile("s_waitcnt lgkmcnt(0)" ::: "memory"); __builtin_amdgcn_s_barrier(); asm volatile("" ::: "memory");
        EPI_LOOP_AI_M { const int row = ai * HALF + wr * 64 + m * 16 + fr;
            const f32x2 t0 = T[row * 4 + 0], t1 = T[row * 4 + 1], t2 = T[row * 4 + 2], t3 = T[row * 4 + 3];
            const float M = fmaxf(fmaxf(t0.x, t1.x), fmaxf(t2.x, t3.x));
            const float S = (t0.y * __builtin_amdgcn_exp2f(t0.x - M) + t1.y * __builtin_amdgcn_exp2f(t1.x - M)) + (t2.y * __builtin_amdgcn_exp2f(t2.x - M) + t3.y * __builtin_amdgcn_exp2f(t3.x - M));
            const float f = __builtin_amdgcn_exp2f(T[row * 4 + wc].x - M) * PSCALE / S;
            unsigned char* rowp = O + (size_t)(u.pm * BM + row) * ldc + u.pn * BM + wc * 32 + 8 * fq;
#pragma unroll
            for (int bj = 0; bj < 2; ++bj) { const f32x4 v0 = acc[ai][bj][m][0] * f, v1 = acc[ai][bj][m][1] * f;
                v2u w; w.x = pk4_fp8(v0[0], v0[1], v0[2], v0[3]); w.y = pk4_fp8(v1[0], v1[1], v1[2], v1[3]);
                *(v2u*)(rowp + bj * HALF) = w; }
            __builtin_amdgcn_sched_barrier(0); }
        asm volatile("s_waitcnt lgkmcnt(0)" ::: "memory"); __builtin_amdgcn_s_barrier(); asm volatile("" ::: "memory");
    }
};
}

constexpr int CONV_RUN = 4;
__device__ __forceinline__ void conv_run(Frame& F, int tok0) {
    const int lane = F.lane, t0 = tok0 % SEQ, c0 = 8 * lane;
    const bf16* p0 = F.PROJ() + (size_t)tok0 * NPROJ + c0;
    float w[3][8], gq[8];
#pragma unroll
    for (int i = 0; i < 3; ++i) { const f32x4 w0 = *(const f32x4*)(F.w_conv() + i * CW + c0), w1 = *(const f32x4*)(F.w_conv() + i * CW + c0 + 4);
#pragma unroll
        for (int j = 0; j < 4; ++j) { w[i][j] = w0[j]; w[i][4 + j] = w1[j]; } }
    { const f32x4 g0 = *(const f32x4*)(F.g_conv() + c0), g1 = *(const f32x4*)(F.g_conv() + c0 + 4);
#pragma unroll
      for (int j = 0; j < 4; ++j) { gq[j] = g0[j]; gq[4 + j] = g1[j]; } }
    float vm2[8], vm1[8];
#pragma unroll
    for (int j = 0; j < 8; ++j) { vm2[j] = 0.f; vm1[j] = 0.f; }
    if (t0 >= 2) { float u[8], gc[8]; unpack8(*(const v4u*)(p0 - 2 * NPROJ), u); unpack8(*(const v4u*)(p0 - 2 * NPROJ + 2 * CW), gc);
#pragma unroll
        for (int j = 0; j < 8; ++j) vm2[j] = gc[j] * u[j]; }
    if (t0 >= 1) { float u[8], gc[8]; unpack8(*(const v4u*)(p0 - NPROJ), u); unpack8(*(const v4u*)(p0 - NPROJ + 2 * CW), gc);
#pragma unroll
        for (int j = 0; j < 8; ++j) vm1[j] = gc[j] * u[j]; }
#pragma unroll
    for (int bt = 0; bt < CONV_RUN; bt += 4) {
        v4u ru[4], rb[4], rc[4];
#pragma unroll
        for (int i = 0; i < 4; ++i) { const bf16* p = p0 + (size_t)(bt + i) * NPROJ; ru[i] = *(const v4u*)p; rb[i] = *(const v4u*)(p + CW); rc[i] = *(const v4u*)(p + 2 * CW); }
#pragma unroll
        for (int i = 0; i < 4; ++i) { float u[8], gb[8], gc[8], y[8]; unpack8(ru[i], u); unpack8(rb[i], gb); unpack8(rc[i], gc);
            float s = 0.f;
#pragma unroll
            for (int j = 0; j < 8; ++j) { const float v0 = gc[j] * u[j]; y[j] = gb[j] * (w[0][j] * vm2[j] + w[1][j] * vm1[j] + w[2][j] * v0); vm2[j] = vm1[j]; vm1[j] = v0; s += y[j] * y[j]; }
            const float rstd = 1.f / sqrtf(wave_sum(s) * (1.f / CW) + EPS);
            v4u o; o.x = pk2(y[0] * rstd * gq[0], y[1] * rstd * gq[1]); o.y = pk2(y[2] * rstd * gq[2], y[3] * rstd * gq[3]);
            o.z = pk2(y[4] * rstd * gq[4], y[5] * rstd * gq[5]); o.w = pk2(y[6] * rstd * gq[6], y[7] * rstd * gq[7]);
            *(v4u*)(F.YMIX() + (size_t)(tok0 + bt + i) * D + c0) = o; }
    }
}

namespace sba {
typedef short bf16x8 __attribute__((ext_vector_type(8)));
typedef short s16x4 __attribute__((ext_vector_type(4)));
typedef float f32x16 __attribute__((ext_vector_type(16)));
typedef short v4i16_t __attribute__((ext_vector_type(4)));
constexpr float EXIT2 = -104.f * 1.4426950408889634f;
constexpr int WLDS = 16384, OST = 4096, OPITCH = 65;
__device__ __forceinline__ s16x4 vtr(const LAS unsigned char* p) { return __builtin_bit_cast(s16x4, __builtin_amdgcn_ds_read_tr16_b64_v4i16((LAS v4i16_t*)p)); }
typedef float f32x2_t __attribute__((ext_vector_type(2))); typedef __bf16 bf16x2_t __attribute__((ext_vector_type(2)));
__device__ __forceinline__ unsigned cvtpk(float lo, float hi) { f32x2_t v = {lo, hi}; bf16x2_t b = __builtin_convertvector(v, bf16x2_t); return __builtin_bit_cast(unsigned, b); }
__device__ __forceinline__ int krow(int r, int hh) { return (r & 3) + 8 * (r >> 2) + 4 * hh; }
struct TagT { static constexpr bool value = true; }; struct TagF { static constexpr bool value = false; };

__device__ __forceinline__ void sb_unit(Frame& F, int b, int h, int qt, LAS unsigned char* wl, const bf16x8 (&Uf)[2]) {
    const int lane = F.lane, r32 = lane & 31, hh = lane >> 5;
    const bf16* base = F.PROJ() + (size_t)b * SEQ * NPROJ + h * SBD;
    const bf16* qp = base + (size_t)(qt * 32 + r32) * NPROJ + PQ + 8 * hh;
    bf16x8 qf[4];
#pragma unroll
    for (int s = 0; s < 4; ++s) qf[s] = *(const bf16x8*)(qp + 16 * s);
    const bf16* kp = base + (size_t)r32 * NPROJ + PK + 8 * hh;
    const bf16* vp = base + (size_t)(lane >> 3) * NPROJ + PV + 8 * (lane & 7);
    const int c = lane & 7;
    const int vw0 = (c >> 2) * 2048 + (c & 3) * 16 + (lane >> 3) * 64;
    const int vb = ((lane >> 4) & 1) * 32 + (lane & 3) * 8 + (4 * hh + ((lane & 15) >> 2)) * 64;
    f32x16 o0, o1;
#pragma unroll
    for (int r = 0; r < 16; ++r) { o0[r] = 0.f; o1[r] = 0.f; }
    float carry = 0.f;
    bf16x8 kf[4]; v4u vr[4];
    { const size_t ko = (size_t)(qt * 32) * NPROJ;
#pragma unroll
      for (int s = 0; s < 4; ++s) kf[s] = *(const bf16x8*)(kp + ko + 16 * s);
#pragma unroll
      for (int i = 0; i < 4; ++i) vr[i] = *(const v4u*)(vp + ko + (size_t)(8 * i) * NPROJ); }
    auto step = [&](auto diag_tag, const int kt) -> bool {
        constexpr bool DIAG = decltype(diag_tag)::value;
        asm volatile("" ::: "memory");
#pragma unroll
        for (int i = 0; i < 4; ++i) *(LAS v4u*)(wl + vw0 + (i & 1) * 512 + (i >> 1) * 1024) = vr[i];
        asm volatile("" ::: "memory");
        bf16x8 kc[4];
#pragma unroll
        for (int s = 0; s < 4; ++s) kc[s] = kf[s];
        if (kt > 0) { const size_t ko = (size_t)((kt - 1) * 32) * NPROJ;
#pragma unroll
            for (int s = 0; s < 4; ++s) kf[s] = *(const bf16x8*)(kp + ko + 16 * s);
#pragma unroll
            for (int i = 0; i < 4; ++i) vr[i] = *(const v4u*)(vp + ko + (size_t)(8 * i) * NPROJ); }
        f32x16 z;
#pragma unroll
        for (int r = 0; r < 16; ++r) z[r] = 0.f;
#pragma unroll
        for (int s = 0; s < 4; ++s) z = __builtin_amdgcn_mfma_f32_32x32x16_bf16(kc[s], qf[s], z, 0, 0, 0);
        f32x16 L; float csum = 0.f;
#pragma unroll
        for (int r = 0; r < 16; ++r) { const float zz = z[r];
            const float e = __builtin_amdgcn_exp2f(-fabsf(zz)); const float lg = __builtin_amdgcn_logf(1.f + e);
            const float sp = __builtin_amdgcn_fmed3f(zz, 0.f, 3.0e38f) + lg;
            if constexpr (DIAG) { const bool valid = krow(r, hh) < r32; L[r] = valid ? -sp : 0.f; } else L[r] = -sp;
            csum += L[r]; }
        bf16x8 Lb[2];
#pragma unroll
        for (int s = 0; s < 2; ++s) { v4u w; w.x = cvtpk(L[8 * s + 0], L[8 * s + 1]); w.y = cvtpk(L[8 * s + 2], L[8 * s + 3]); w.z = cvtpk(L[8 * s + 4], L[8 * s + 5]); w.w = cvtpk(L[8 * s + 6], L[8 * s + 7]); Lb[s] = __builtin_bit_cast(bf16x8, w); }
        f32x16 Y;
#pragma unroll
        for (int r = 0; r < 16; ++r) Y[r] = carry;
        Y = __builtin_amdgcn_mfma_f32_32x32x16_bf16(Uf[0], Lb[0], Y, 0, 0, 0);
        Y = __builtin_amdgcn_mfma_f32_32x32x16_bf16(Uf[1], Lb[1], Y, 0, 0, 0);
#pragma unroll
        for (int r = 0; r < 16; ++r) { const float a = __builtin_amdgcn_exp2f(z[r] + L[r] + Y[r]);
            if constexpr (DIAG) { const bool valid = krow(r, hh) < r32; z[r] = valid ? a : 0.f; } else z[r] = a; }
        bf16x8 Pa[2];
#pragma unroll
        for (int s = 0; s < 2; ++s) { v4u w; w.x = cvtpk(z[8 * s + 0], z[8 * s + 1]); w.y = cvtpk(z[8 * s + 2], z[8 * s + 3]); w.z = cvtpk(z[8 * s + 4], z[8 * s + 5]); w.w = cvtpk(z[8 * s + 6], z[8 * s + 7]); Pa[s] = __builtin_bit_cast(bf16x8, w); }
        { auto rr = __builtin_amdgcn_permlane32_swap(__float_as_uint(csum), __float_as_uint(csum), false, false); carry += __uint_as_float(rr[0]) + __uint_as_float(rr[1]); }
#pragma unroll
        for (int d0 = 0; d0 < 2; ++d0)
#pragma unroll
            for (int ks = 0; ks < 2; ++ks) { const s16x4 lo = vtr(wl + vb + d0 * 2048 + ks * 1024), hi = vtr(wl + vb + d0 * 2048 + ks * 1024 + 512);
                const bf16x8 vf = (bf16x8){lo[0], lo[1], lo[2], lo[3], hi[0], hi[1], hi[2], hi[3]};
                if (d0 == 0) o0 = __builtin_amdgcn_mfma_f32_32x32x16_bf16(Pa[ks], vf, o0, 0, 0, 0); else o1 = __builtin_amdgcn_mfma_f32_32x32x16_bf16(Pa[ks], vf, o1, 0, 0, 0); }
        return __all(carry < EXIT2) != 0;
    };
    if (!step(TagT{}, qt)) for (int kt = qt - 1; kt >= 0; --kt) if (step(TagF{}, kt)) break;
    asm volatile("" ::: "memory");
    LAS float* ost = (LAS float*)(wl + OST);
#pragma unroll
    for (int r = 0; r < 16; ++r) { const int q = krow(r, hh); ost[q * OPITCH + r32] = o0[r]; ost[q * OPITCH + 32 + r32] = o1[r]; }
    asm volatile("" ::: "memory");
    const int q = lane >> 1, half = lane & 1;
    float v[32]; float ss = 0.f;
#pragma unroll
    for (int i = 0; i < 32; ++i) { v[i] = ost[q * OPITCH + half * 32 + i]; ss += v[i] * v[i]; }
    ss += __shfl_xor(ss, 1);
    const float rstd = 1.f / sqrtf(ss * (1.f / SBD) + EPS);
    const float* g = F.g_sb() + h * SBD + half * 32;
    bf16* orow = F.YMIX() + (size_t)(b * SEQ + qt * 32 + q) * D + CW + h * SBD + half * 32;
#pragma unroll
    for (int i = 0; i < 4; ++i) { const f32x4 g0 = *(const f32x4*)(g + 8 * i), g1 = *(const f32x4*)(g + 8 * i + 4);
        v4u w; w.x = cvtpk(v[8 * i + 0] * rstd * g0[0], v[8 * i + 1] * rstd * g0[1]); w.y = cvtpk(v[8 * i + 2] * rstd * g0[2], v[8 * i + 3] * rstd * g0[3]);
        w.z = cvtpk(v[8 * i + 4] * rstd * g1[0], v[8 * i + 5] * rstd * g1[1]); w.w = cvtpk(v[8 * i + 6] * rstd * g1[2], v[8 * i + 7] * rstd * g1[3]);
        *(v4u*)(orow + 8 * i) = w; }
    asm volatile("" ::: "memory");
}
__device__ __forceinline__ void sb_phase(Frame& F, int gw, int NGW) {
    const int lane = F.lane, r32 = lane & 31, hh = lane >> 5;
    bf16x8 Uf[2];
#pragma unroll
    for (int s = 0; s < 2; ++s)
#pragma unroll
        for (int j = 0; j < 8; ++j) { const int k = 16 * s + 8 * (j >> 2) + 4 * hh + (j & 3); Uf[s][j] = (k > r32) ? (short)0x3F80 : (short)0; }
    LAS unsigned char* wl = F.lds + F.wave * WLDS;
    for (int u = gw; u < BATCH * SBH * (SEQ / 32); u += NGW) { const int qt = u % (SEQ / 32), bh = u / (SEQ / 32); sb_unit(F, bh / SBH, bh % SBH, qt, wl, Uf); }
}
}

constexpr int RT_OFF = 132096;
constexpr int CW_ECNT = 8192;
__device__ __forceinline__ void router_phase(Frame& F) {
    typedef short bf16x8 __attribute__((ext_vector_type(8))); typedef float f32x16 __attribute__((ext_vector_type(16)));
    constexpr int RP = 65;
    LAS float* red = (LAS float*)F.lds;
    LAS float* ssq = red + 4 * 64 * RP;
    LAS float* rstdL = ssq + 256;
    LAS int* hist = (LAS int*)(F.lds + RT_OFF); LAS int* base = hist + 32; LAS int* aexp = base + 32; LAS int* arank = aexp + 256; LAS float* agate = (LAS float*)(arank + 256);
    const int lane = F.lane, r32 = lane & 31, hh = lane >> 5, grp = F.wave & 1, q = F.wave >> 1;
    int* ecnt = (int*)(F.a.ws + WS_CTL) + CW_ECNT;
    const bf16* wp0 = F.WrT() + (size_t)r32 * D + q * 256 + 8 * hh;
    for (int tb = F.vcu; tb < NTOK / 64; tb += F.G) {
        if (F.tid < NE) hist[F.tid] = 0;
        const int tl = grp * 32 + r32, token = tb * 64 + tl;
        const bf16* xp = F.X2B() + (size_t)token * D + q * 256 + 8 * hh;
        f32x16 ch, cl;
#pragma unroll
        for (int r = 0; r < 16; ++r) { ch[r] = 0.f; cl[r] = 0.f; }
        float sq = 0.f;
#pragma unroll
        for (int hf = 0; hf < 2; ++hf) {
            bf16x8 af[8], bhi[8], blo[8];
#pragma unroll
            for (int s = 0; s < 8; ++s) { af[s] = *(const bf16x8*)(xp + 16 * (8 * hf + s)); bhi[s] = *(const bf16x8*)(wp0 + 16 * (8 * hf + s)); blo[s] = *(const bf16x8*)(wp0 + (size_t)32 * D + 16 * (8 * hf + s)); }
#pragma unroll
            for (int s = 0; s < 8; ++s) { ch = __builtin_amdgcn_mfma_f32_32x32x16_bf16(af[s], bhi[s], ch, 0, 0, 0); cl = __builtin_amdgcn_mfma_f32_32x32x16_bf16(af[s], blo[s], cl, 0, 0, 0);
                float f[8]; unpack8(__builtin_bit_cast(v4u, af[s]), f);
#pragma unroll
                for (int j = 0; j < 8; ++j) sq += f[j] * f[j]; }
            __builtin_amdgcn_sched_barrier(0);
        }
        { auto rr = __builtin_amdgcn_permlane32_swap(__float_as_uint(sq), __float_as_uint(sq), false, false); sq = __uint_as_float(rr[0]) + __uint_as_float(rr[1]); }
        if (hh == 0) ssq[q * 64 + tl] = sq;
#pragma unroll
        for (int r = 0; r < 16; ++r) { const int t = grp * 32 + (r & 3) + 8 * (r >> 2) + 4 * hh; red[(q * 64 + t) * RP + r32] = ch[r]; red[(q * 64 + t) * RP + 32 + r32] = cl[r]; }
        __syncthreads();
        if (F.wave == 0) {
            const int t = lane;
            const float rstd = 1.f / sqrtf(((ssq[t] + ssq[64 + t]) + (ssq[128 + t] + ssq[192 + t])) * (1.f / D) + EPS);
            rstdL[t] = rstd;
            float lg[32];
#pragma unroll
            for (int e = 0; e < 32; ++e) { float v = 0.f;
#pragma unroll
                for (int qq = 0; qq < 4; ++qq) v += red[(qq * 64 + t) * RP + e] + red[(qq * 64 + t) * RP + 32 + e];
                lg[e] = v * rstd + F.b_router()[e]; }
            float tv[4]; int ti[4];
#pragma unroll
            for (int r = 0; r < 4; ++r) { float m = -INFINITY; int mi = 0;
#pragma unroll
                for (int e = 0; e < 32; ++e) { const bool gt = lg[e] > m; m = gt ? lg[e] : m; mi = gt ? e : mi; }
                tv[r] = m; ti[r] = mi;
#pragma unroll
                for (int e = 0; e < 32; ++e) lg[e] = (e == mi) ? -INFINITY : lg[e]; }
            const float e1 = __expf(tv[1] - tv[0]), e2 = __expf(tv[2] - tv[0]), e3 = __expf(tv[3] - tv[0]); const float inv = 1.f / (1.f + e1 + e2 + e3);
            const float gt[4] = {inv, e1 * inv, e2 * inv, e3 * inv};
#pragma unroll
            for (int r = 0; r < 4; ++r) { const int a = t * 4 + r; aexp[a] = ti[r]; agate[a] = gt[r]; arank[a] = atomicAdd((int*)&hist[ti[r]], 1); }
        }
        __syncthreads();
        { const float rs = rstdL[tl] * XSCALE; unsigned char* op = F.XB8() + (size_t)token * D + q * 256 + 8 * hh;
#pragma unroll
          for (int s = 0; s < 16; ++s) { float f[8]; unpack8(*(const v4u*)(xp + 16 * s), f);
              v2u w; w.x = pk4_fp8(f[0] * rs, f[1] * rs, f[2] * rs, f[3] * rs); w.y = pk4_fp8(f[4] * rs, f[5] * rs, f[6] * rs, f[7] * rs); *(v2u*)(op + 16 * s) = w; } }
        if (F.tid < NE) { const int h = hist[F.tid]; base[F.tid] = h ? atomicAdd(ecnt + F.tid, h) : 0; }
        __syncthreads();
        if (F.tid < 256) { const int a = F.tid, e = aexp[a], rank = base[e] + arank[a], tk = tb * 64 + (a >> 2);
            F.LTOK()[e * NTOK + rank] = tk; F.LGATE()[e * NTOK + rank] = agate[a]; F.SLOT()[tk * 4 + (a & 3)] = rank; F.TOPI()[tk * 4 + (a & 3)] = e; }
        __syncthreads();
    }
}

struct MoeTab { LAS int* cnt; LAS int* pst; LAS int* texp; LAS int* gl; };
__device__ __forceinline__ MoeTab moe_tab(Frame& F) { MoeTab T; T.cnt = (LAS int*)(F.lds + RT_OFF); T.pst = T.cnt + 32; T.texp = T.pst + 40; T.gl = (LAS int*)(F.lds + RT_OFF + 2048); return T; }
__device__ __forceinline__ int moe_setup(Frame& F, const MoeTab& T) {
    const int* ecnt = (const int*)(F.a.ws + WS_CTL) + CW_ECNT;
    __syncthreads();
    if (F.tid < NE) T.cnt[F.tid] = __hip_atomic_load(ecnt + F.tid, __ATOMIC_RELAXED, __HIP_MEMORY_SCOPE_AGENT);
    __syncthreads();
    if (F.tid == 0) { int p = 0; for (int e = 0; e < NE; ++e) { T.pst[e] = p; const int nt = (T.cnt[e] + 255) >> 8; for (int j = 0; j < nt; ++j) T.texp[(p >> 8) + j] = e; p += nt << 8; } T.pst[NE] = p; }
    __syncthreads();
    return T.pst[NE] >> 8;
}

__device__ __forceinline__ void final_phase(Frame& F, float* dst, const LAS int* pst) {
    const int gw = F.vcu * NWAVES + F.wave, NGW = F.G * NWAVES, lane = F.lane;
    f32x4 gf[4];
#pragma unroll
    for (int j = 0; j < 2; ++j) { gf[2 * j] = *(const f32x4*)(F.g_final() + 8 * lane + 512 * j); gf[2 * j + 1] = *(const f32x4*)(F.g_final() + 8 * lane + 512 * j + 4); }
    for (int t0 = gw * 2; t0 < NTOK; t0 += NGW * 2) {
        int sl[2][4]; f32x4 v[2][4]; v2u y[2][4][2];
#pragma unroll
        for (int tt = 0; tt < 2; ++tt)
#pragma unroll
            for (int k = 0; k < 4; ++k) sl[tt][k] = pst[F.TOPI()[(t0 + tt) * 4 + k]] + F.SLOT()[(t0 + tt) * 4 + k];
#pragma unroll
        for (int tt = 0; tt < 2; ++tt)
#pragma unroll
            for (int j = 0; j < 2; ++j) { float f[8]; unpack8(__builtin_nontemporal_load((const v4u*)(F.X2B() + (size_t)(t0 + tt) * D + 8 * lane + 512 * j)), f); v[tt][2 * j] = (f32x4){f[0], f[1], f[2], f[3]}; v[tt][2 * j + 1] = (f32x4){f[4], f[5], f[6], f[7]}; }
#pragma unroll
        for (int tt = 0; tt < 2; ++tt)
#pragma unroll
            for (int k = 0; k < 4; ++k)
#pragma unroll
                for (int j = 0; j < 2; ++j) y[tt][k][j] = __builtin_nontemporal_load((const v2u*)((const unsigned char*)F.Y() + (size_t)sl[tt][k] * D + 8 * lane + 512 * j));
#pragma unroll
        for (int tt = 0; tt < 2; ++tt) {
#pragma unroll
            for (int k = 0; k < 4; ++k)
#pragma unroll
                for (int j = 0; j < 2; ++j) { const pg8::f32x2 f0 = __builtin_amdgcn_cvt_pk_f32_fp8((int)y[tt][k][j].x, false), f1 = __builtin_amdgcn_cvt_pk_f32_fp8((int)y[tt][k][j].x, true),
                                                  f2 = __builtin_amdgcn_cvt_pk_f32_fp8((int)y[tt][k][j].y, false), f3 = __builtin_amdgcn_cvt_pk_f32_fp8((int)y[tt][k][j].y, true);
                    constexpr float is = 1.f / pg8::Y8SCALE;
                    v[tt][2 * j][0] += f0.x * is; v[tt][2 * j][1] += f0.y * is; v[tt][2 * j][2] += f1.x * is; v[tt][2 * j][3] += f1.y * is;
                    v[tt][2 * j + 1][0] += f2.x * is; v[tt][2 * j + 1][1] += f2.y * is; v[tt][2 * j + 1][2] += f3.x * is; v[tt][2 * j + 1][3] += f3.y * is; }
            float s = 0.f;
#pragma unroll
            for (int j = 0; j < 4; ++j) s += (v[tt][j].x * v[tt][j].x + v[tt][j].y * v[tt][j].y) + (v[tt][j].z * v[tt][j].z + v[tt][j].w * v[tt][j].w);
            const float rstd = 1.f / sqrtf(wave_sum(s) * (1.f / D) + EPS);
#pragma unroll
            for (int j = 0; j < 2; ++j) { float* xp = dst + (size_t)(t0 + tt) * D + 8 * lane + 512 * j; __builtin_nontemporal_store(v[tt][2 * j] * rstd * gf[2 * j], (f32x4*)xp); __builtin_nontemporal_store(v[tt][2 * j + 1] * rstd * gf[2 * j + 1], (f32x4*)(xp + 4)); }
        }
    }
}

constexpr int NPHASE = 13;
#ifndef NSTREAM
#define NSTREAM 96
#endif
#ifndef MOE_WGM
#define MOE_WGM 4
#endif
#ifndef PROBE_DUP
#define PROBE_DUP -1
#endif
__global__ void __launch_bounds__(NWAVES * 64, 2) fwd_kernel(Args args) {
    extern __shared__ __attribute__((aligned(16))) unsigned char lds[];
    Frame F(args);
    F.lds = (LAS unsigned char*)lds;
    F.tid = threadIdx.x; F.lane = F.tid & 63; F.wave = __builtin_amdgcn_readfirstlane(F.tid >> 6);
    F.G = gridDim.x; { const int bx = blockIdx.x; F.vcu = (F.G % 8 == 0) ? (bx % 8) * (F.G / 8) + bx / 8 : bx; }
    unsigned char* ws = args.ws;
    for (int u = F.tid; u < (LDS_BYTES - LDSCTL_OFF) / 4; u += NWAVES * 64) ((LAS unsigned*)(F.lds + LDSCTL_OFF))[u] = 0u;
    __syncthreads();
    volatile LAS unsigned* MISC = (volatile LAS unsigned*)(F.lds + MISC_OFF);
    const bool one = (args.ph_hi - args.ph_lo) > 1;
    XcdBarrier bar; bar.bar = (unsigned*)(ws + WS_CTL) + CW_BAR; bar.x = 0; bar.st = nullptr;
    if (one) bar = xcd_barrier_post((unsigned*)(ws + WS_CTL) + CW_BAR, MISC + 8);
    const int lo = args.ph_lo, hi = args.ph_hi;
#define IN(k) (lo <= (k) && (k) < hi)
#define NEXTPH(k) ((k) == 8 ? 10 : (k) == 5 ? 7 : (k) == 3 ? 5 : (k) + 1)
#define SEAM(k) do { if (IN(k) && IN(NEXTPH(k))) { xcd_barrier(bar); if (PROBE_DUP == 99) xcd_barrier(bar); } } while (0)
    const int gw = F.vcu * NWAVES + F.wave, NGW = F.G * NWAVES;

    if (IN(0)) { p0_prologue(F); if (PROBE_DUP == 0) p0_prologue(F); SEAM(0); }
    if (IN(1)) {
        static_assert(NSTREAM == 96 && I_P1 == NSTREAM * NWAVES * 14 && (NTOK / 256) * (NPROJ / 256) == 4 * (256 - NSTREAM) + 128, "work split of the two roles");
        if ((int)blockIdx.x < NSTREAM && F.G == 256) {
            LAS unsigned* scr = (LAS unsigned*)(F.lds + F.wave * 16384); tr_tables(F);
            tr_run<true>(F, (int)blockIdx.x * NWAVES + F.wave, NSTREAM * NWAVES, I_P1, scr);
        } else if (F.G == 256) { const int c = (int)blockIdx.x - NSTREAM;
            { pg8::Gemm g{F.XN(), F.WinT(), D, D, D}; pg8::StaticOrder S; S.init(NTOK / 256, NPROJ / 256, F.G - NSTREAM, c, D, D, nullptr);
              pg8::EpiBf16 E{F.PROJ(), NPROJ, PQ / 256, PK / 256, SBQSCALE}; pg8::gemm_phase<pg8::EpiBf16, pg8::StaticOrder, true>(F.lds, g, S, E); if (PROBE_DUP == 1) { __syncthreads(); pg8::gemm_phase<pg8::EpiBf16, pg8::StaticOrder, true>(F.lds, g, S, E); } }
            if (c >= 128) { VM_WAIT(); __syncthreads();
                pg8::Gemm g{F.MN(), F.WxkvT(), D, D, D}; pg8::StaticOrder S; S.init(NMEM / 256, 2 * D / 256, 32, c - 128, D, D, nullptr);
                pg8::EpiKV E{F.KVX()}; pg8::gemm_phase<pg8::EpiKV, pg8::StaticOrder, true>(F.lds, g, S, E); } }
        SEAM(1); }
    if (IN(2)) {
        const int nkv = 32;
        if ((int)blockIdx.x < nkv) {
#pragma unroll 1
            for (int j4 = 0; j4 < 4; ++j4) { const int id = (int)blockIdx.x * 4 + j4, idx = id & 63, bh = idx >> 2, b = bh >> 2, h = bh & 3, part = idx & 3;
                const bool mt = id < 64;
                pg8::Gemm g{mt ? F.KVX() : F.WxoT(), mt ? F.WxqB() : F.KVX(), mt ? 2 * D : D, mt ? D : 2 * D, XAD};
                pg8::OneUnit S; S.u0.aux = 0; S.u0.pm = mt ? 0 : part; S.u0.pn = mt ? part : h;
                S.u0.a_off = mt ? (long)b * MEML * 2 * D + h * XAD : (long)part * 256 * D + h * XAD;
                S.u0.b_off = mt ? (long)part * 256 * D + h * XAD : (long)b * MEML * 2 * D + D + h * XAD;
                pg8::EpiF8 E{mt ? F.Mt8() + (size_t)b * D * D + (size_t)(h * 256) * D : F.Vt8() + (size_t)b * D * D, D, MVSCALE};
                pg8::gemm_phase<pg8::EpiF8, pg8::OneUnit, true>(F.lds, g, S, E);
                VM_WAIT(); __syncthreads(); }
        }
        if ((int)blockIdx.x >= nkv) {
            const int bx = (int)blockIdx.x - nkv, Gs = F.G - nkv; const int vc = (Gs % 8 == 0) ? (bx % 8) * (Gs / 8) + bx / 8 : bx;
            const int gws = vc * NWAVES + F.wave, NGWs = Gs * NWAVES;
            sba::sb_phase(F, gws, NGWs); if (PROBE_DUP == 2) sba::sb_phase(F, gws, NGWs);
            { constexpr int NRUN = NTOK / CONV_RUN; const int nheavy = (BATCH * SBH * (SEQ / 32)) % NGWs;
              if (gws < nheavy) { if (gws < NRUN) conv_run(F, gws * CONV_RUN); }
              else for (int tr = nheavy + (gws - nheavy); tr < NRUN; tr += NGWs - nheavy) conv_run(F, tr * CONV_RUN); }
        }
        SEAM(2);
    }
    if (IN(3)) {
        { pg8::Gemm g{F.YMIX(), F.WoutT(), D, D, D}; pg8::StaticOrder S; S.init(NTOK / 256, D / 256, F.G, (int)blockIdx.x, D, D, nullptr);
            pg8::EpiResIn E{F.x(), F.XA(), F.SSP1(), F.XA8()}; pg8::gemm_phase<pg8::EpiResIn, pg8::StaticOrder, true>(F.lds, g, S, E); if (PROBE_DUP == 3) { __syncthreads(); pg8::gemm_phase<pg8::EpiResIn, pg8::StaticOrder, true>(F.lds, g, S, E); } }
        SEAM(3); }
    if (IN(5)) {
        { const int un = F.vcu, rt = un >> 2, h = un & 3, b = rt / (SEQ / 256);
            pg8::Gemm g{(const bf16*)F.XA8(), (const bf16*)F.Mt8(), D / 2, D / 2, D / 2}; pg8::OneUnit S; S.u0.pm = rt; S.u0.pn = h; S.u0.aux = 0;
            S.u0.a_off = (long)rt * 256 * (D / 2); S.u0.b_off = (long)b * D * (D / 2) + (long)(h * 256) * (D / 2);
            pg8::EpiSoftmax E{F.PX8(), D, F.SSP1()}; pg8::gemm_phase<pg8::EpiSoftmax, pg8::OneUnit, false, true>(F.lds, g, S, E);
            if (PROBE_DUP == 5) { __syncthreads(); pg8::gemm_phase<pg8::EpiSoftmax, pg8::OneUnit, false, true>(F.lds, g, S, E); } }
        SEAM(5); }
    if (IN(7)) {
        { const int un = F.vcu, rt = un >> 2, pn = un & 3, b = rt / (SEQ / 256);
            pg8::Gemm g{(const bf16*)F.PX8(), (const bf16*)F.Vt8(), D / 2, D / 2, D / 2}; pg8::OneUnit S; S.u0.pm = rt; S.u0.pn = pn; S.u0.aux = 0;
            S.u0.a_off = (long)rt * 256 * (D / 2); S.u0.b_off = (long)b * D * (D / 2) + (long)(pn * 256) * (D / 2);
            pg8::EpiResB E{F.XA(), F.X2B(), 1.f / (PSCALE * MVSCALE)}; pg8::gemm_phase<pg8::EpiResB, pg8::OneUnit, true, true>(F.lds, g, S, E);
            if (PROBE_DUP == 7) { __syncthreads(); pg8::gemm_phase<pg8::EpiResB, pg8::OneUnit, true, true>(F.lds, g, S, E); } }
        SEAM(7); }
    if (IN(8)) { router_phase(F); if (PROBE_DUP == 8) { __syncthreads(); } SEAM(8); }
    if (IN(10)) {
        const MoeTab T = moe_tab(F); const int nt = moe_setup(F, T);
        pg8::StaticOrder S; S.init(nt, NGU / 256, F.G, (int)blockIdx.x, D / 2, D / 2, T.texp, MOE_WGM);
        { int tok[9]; float gt[9]; int gidx[9];
#pragma unroll
          for (int ui = 0; ui < 9; ++ui) { pg8::Unit u; tok[ui] = -1; gidx[ui] = -1; gt[ui] = 0.f;
              if (S.next(ui, u) && F.tid < 256) { const int e = u.aux, rank = u.pm * 256 + F.tid - T.pst[e]; const bool real = rank < T.cnt[e];
                  tok[ui] = real ? F.LTOK()[e * NTOK + rank] : 0;
                  if (u.pn == 0) { gidx[ui] = u.pm * 256 + F.tid; gt[ui] = real ? F.LGATE()[e * NTOK + rank] : 0.f; } } }
#pragma unroll
          for (int ui = 0; ui < 9; ++ui) { if (tok[ui] >= 0) T.gl[ui * 256 + F.tid] = tok[ui]; if (gidx[ui] >= 0) F.RGATE()[gidx[ui]] = gt[ui]; } }
        __syncthreads();
        pg8::Gemm g{(const bf16*)F.XB8(), (const bf16*)F.WguT8(), D / 2, D / 2, D / 2, T.gl};
        pg8::EpiGU E{F.ACT8(), F.b_gu()}; pg8::gemm_phase<pg8::EpiGU, pg8::StaticOrder, true, true>(F.lds, g, S, E);
        if (PROBE_DUP == 10) { __syncthreads(); pg8::gemm_phase<pg8::EpiGU, pg8::StaticOrder, true, true>(F.lds, g, S, E); }
        { const int rem = (nt * (NGU / 256)) % F.G, c = (int)blockIdx.x, nlw = rem ? F.G - rem : F.G;
          if (rem == 0 || c >= rem) { VM_WAIT(); __syncthreads();
              LAS unsigned* scr = (LAS unsigned*)(F.lds + F.wave * 16384); tr_run<true, true>(F, I_P1 + (rem ? c - rem : c) * NWAVES + F.wave, nlw * NWAVES, I_MOE, scr); } }
        if (PROBE_DUP == 110) { xcd_barrier(bar); pg8::gemm_phase<pg8::EpiGU, pg8::StaticOrder, true, true>(F.lds, g, S, E); }
        SEAM(10); }
    if (IN(11)) {
        const MoeTab T = moe_tab(F); const int nt = IN(10) ? (T.pst[NE] >> 8) : moe_setup(F, T);
        pg8::Gemm g{(const bf16*)F.ACT8(), (const bf16*)F.WdT8(), D / 2, D / 2, D / 2}; pg8::StaticOrder S; S.init(nt, D / 256, F.G, (int)blockIdx.x, D / 2, D / 2, T.texp, MOE_WGM);
        pg8::EpiDown E{(unsigned char*)F.Y(), F.b_down(), F.RGATE()}; pg8::gemm_phase<pg8::EpiDown, pg8::StaticOrder, true, true>(F.lds, g, S, E);
        if (PROBE_DUP == 11) { __syncthreads(); pg8::gemm_phase<pg8::EpiDown, pg8::StaticOrder, true, true>(F.lds, g, S, E); }
        SEAM(11); }
    if (IN(12)) { const MoeTab T = moe_tab(F); if (!IN(10)) (void)moe_setup(F, T); if (PROBE_DUP == 12) final_phase(F, (float*)F.ACT8(), T.pst); final_phase(F, F.out(), T.pst); }
#undef IN
#undef SEAM
}

#ifndef ONE_LAUNCH
#define ONE_LAUNCH 1
#endif
extern "C" void kernel_launch(void* const* d_in, const int* in_sizes, int n_in, void* d_out, int out_size, void* d_ws, size_t ws_size, hipStream_t stream) {
    static int grid = 0;
    if (grid == 0) {
        if (n_in != 21 || in_sizes[0] != NTOK * D || out_size != NTOK * D || ws_size < WS_END) { fprintf(stderr, "kernel_launch: unexpected shapes (n_in %d, in0 %d, out %d, ws %zu); nothing launched\n", n_in, n_in > 0 ? in_sizes[0] : -1, out_size, ws_size); grid = -1; return; }
        if (hipFuncSetAttribute((const void*)fwd_kernel, hipFuncAttributeMaxDynamicSharedMemorySize, LDS_BYTES) != hipSuccess) { fprintf(stderr, "kernel_launch: hipFuncSetAttribute failed\n"); grid = -1; return; }
        int dev = 0, cus = 0, per_cu = 0;
        (void)hipGetDevice(&dev); (void)hipDeviceGetAttribute(&cus, hipDeviceAttributeMultiprocessorCount, dev);
        if (hipOccupancyMaxActiveBlocksPerMultiprocessor(&per_cu, (const void*)fwd_kernel, NWAVES * 64, LDS_BYTES) != hipSuccess || per_cu < 1) fprintf(stderr, "kernel_launch: occupancy query reports %d blocks per CU\n", per_cu);
        (void)hipGetLastError();
        grid = 256;
        if (cus < 256) fprintf(stderr, "kernel_launch: device has %d CUs; this kernel needs 256 co-resident workgroups\n", cus);
    }
    if (grid < 0) return;
    (void)hipMemsetAsync((char*)d_ws + WS_CTL, 0, CTL_ZERO_BYTES, stream);
    Args a{};
    for (int i = 0; i < 21; ++i) a.in[i] = (const float*)d_in[i];
    a.out = (float*)d_out; a.ws = (unsigned char*)d_ws;
#if ONE_LAUNCH
    a.ph_lo = 0; a.ph_hi = NPHASE;
    hipLaunchKernelGGL(fwd_kernel, dim3(grid), dim3(NWAVES * 64), LDS_BYTES, stream, a);
#else
    for (int p = 0; p < NPHASE; ++p) { a.ph_lo = p; a.ph_hi = p + 1; hipLaunchKernelGGL(fwd_kernel, dim3(grid), dim3(NWAVES * 64), LDS_BYTES, stream, a); }
#endif
}
```

```cpp
#include <hip/hip_runtime.h>
#include <cstdio>
#include <cstdint>

#define GAS __attribute__((address_space(1)))
#define LAS __attribute__((address_space(3)))
typedef unsigned short bf16;
typedef unsigned v4u __attribute__((ext_vector_type(4)));
typedef unsigned v2u __attribute__((ext_vector_type(2)));
typedef float f32x4 __attribute__((ext_vector_type(4)));
typedef GAS unsigned gu32;
#define RLX_AGENT __ATOMIC_RELAXED, __HIP_MEMORY_SCOPE_AGENT
#define LDS_WAIT() asm volatile("s_waitcnt lgkmcnt(0)" ::: "memory")
#define VM_WAIT() asm volatile("s_waitcnt vmcnt(0)" ::: "memory")

constexpr int BATCH = 4, SEQ = 4096, D = 1024, NTOK = BATCH * SEQ, MEML = 256, NMEM = BATCH * MEML;
constexpr int CW = 512, SBH = 8, SBD = 64, NPROJ = 3072;
constexpr int PQ = 1536, PK = 2048, PV = 2560;
constexpr int XAH = 4, XAD = 256;
constexpr int NE = 32, TOPK = 4, NGU = 2048;
constexpr float EPS = 1e-6f;
constexpr int MAXT = 288, MAXROWS = MAXT * 256;
constexpr float QXSCALE = 0.0625f * 1.4426950408889634f;
constexpr float SBQSCALE = 0.125f * 1.4426950408889634f;
constexpr int NWAVES = 8;

constexpr size_t MiB = 1u << 20;
constexpr size_t WS_CTL = 0, CTL_ZERO_OFF = 16384, CTL_ZERO_BYTES = 20480;
constexpr size_t WS_WIN = 2 * MiB, WS_WOUT = 8 * MiB, WS_WXQ = 10 * MiB, WS_WXKV = 12 * MiB, WS_WXO = 16 * MiB;
constexpr size_t WS_MN = 18 * MiB, WS_KVX = 20 * MiB, WS_VXT = 24 * MiB, WS_MISC = 26 * MiB;
constexpr size_t WS_WGU = 32 * MiB, WS_WD = 160 * MiB, WS_XN = 224 * MiB, WS_PROJ = 256 * MiB, WS_YMIX = 352 * MiB;
constexpr size_t WS_XA = 384 * MiB, WS_QX = 416 * MiB, WS_PX = 448 * MiB, WS_OX = 480 * MiB;
constexpr size_t WS_XG = 512 * MiB, WS_ACT = 656 * MiB, WS_Y = 800 * MiB, WS_END = 944 * MiB;
constexpr size_t MS_SSP1 = 0, MS_RSTD2 = 256 * 1024, MS_TOPI = 320 * 1024, MS_GATE = 576 * 1024, MS_CNT = 832 * 1024, MS_SLOT = 864 * 1024,
                 MS_RTOK = 1120 * 1024, MS_RGATE = 1408 * 1024, MS_TEXP = 1696 * 1024, MS_NT = 1700 * 1024;
constexpr int CW_BAR = 4096;
static_assert((size_t)CW_BAR * 4 >= CTL_ZERO_OFF && (size_t)(8192 + 64) * 4 <= CTL_ZERO_OFF + CTL_ZERO_BYTES, "the per-call memset must cover the barrier words and the expert counters");

__device__ __forceinline__ float bf2f(unsigned v) { return __uint_as_float(v << 16); }
__device__ __forceinline__ unsigned f2bf(float f) { unsigned u = __builtin_bit_cast(unsigned, f); return (u + 0x7fffu + ((u >> 16) & 1u)) >> 16; }
__device__ __forceinline__ unsigned pk2(float lo, float hi) { return f2bf(lo) | (f2bf(hi) << 16); }
__device__ __forceinline__ float wave_sum(float v) {
#pragma unroll
    for (int o = 1; o < 64; o <<= 1) v += __shfl_xor(v, o);
    return v;
}
__device__ __forceinline__ float wave_max(float v) {
#pragma unroll
    for (int o = 1; o < 64; o <<= 1) v = fmaxf(v, __shfl_xor(v, o));
    return v;
}
__device__ __forceinline__ void unpack8(v4u w, float* f) {
    f[0] = bf2f(w.x & 0xffffu); f[1] = bf2f(w.x >> 16); f[2] = bf2f(w.y & 0xffffu); f[3] = bf2f(w.y >> 16);
    f[4] = bf2f(w.z & 0xffffu); f[5] = bf2f(w.z >> 16); f[6] = bf2f(w.w & 0xffffu); f[7] = bf2f(w.w >> 16);
}

__device__ __forceinline__ void st16_wt(void* p, v4u v) { asm volatile("global_store_dwordx4 %0, %1, off sc1\n\ts_nop 1" :: "v"(p), "v"(v) : "memory"); }

#define XB_TMO      128
#define XB_XCNT(j)  (256  + 64 * (j))
#define XB_XSUB(j)  (1280 + 64 * (j))
#define XB_XGEN(j)  (2304 + 64 * (j))
#define XB_TOP      3328
#define XB_TOPGEN   3392
#define XCD_BAR_WORDS 3456
#define XB_SPIN_CAP (1u << 18)
__device__ __forceinline__ unsigned xb_ld(unsigned* p)              { return __hip_atomic_load(p, __ATOMIC_RELAXED, __HIP_MEMORY_SCOPE_AGENT); }
__device__ __forceinline__ unsigned xb_add(unsigned* p, unsigned v) { return __hip_atomic_fetch_add(p, v, __ATOMIC_RELAXED, __HIP_MEMORY_SCOPE_AGENT); }
__device__ __forceinline__ unsigned xb_xcc_id() { return (unsigned)__builtin_amdgcn_s_getreg((3 << 11) | 20) & 0xFu; }
#define XB_SPIN(cond, bar) do { unsigned _sp = 0; while (cond) { __builtin_amdgcn_s_sleep(1); \
    if ((++_sp & 255u) == 0u) { if (xb_ld(&(bar)[XB_TMO])) break; if (_sp > XB_SPIN_CAP) { atomicAdd(&(bar)[XB_TMO], 1u); break; } } } } while (0)
struct XcdBarrier { unsigned* bar; unsigned x; volatile LAS unsigned* st; };
__device__ __forceinline__ XcdBarrier xcd_barrier_post(unsigned* bar, volatile LAS unsigned* st) {
    XcdBarrier b; b.bar = bar; b.x = xb_xcc_id(); b.st = st;
    if (threadIdx.x == 0) (void)xb_add(&bar[XB_XCNT(b.x)], 1u);
    return b;
}
__device__ __forceinline__ void xcd_barrier_complete(unsigned* bar, unsigned x, unsigned& nloc, unsigned& nx) {
    const unsigned G = gridDim.x * gridDim.y * gridDim.z;
    unsigned sum, cnt, mine, sp = 0u;
    for (;;) {
        sum = 0u; cnt = 0u; mine = 0u;
#pragma unroll
        for (unsigned j = 0; j < 16; ++j) { const unsigned c = xb_ld(&bar[XB_XCNT(j)]); sum += c; cnt += (c > 0u) ? 1u : 0u; mine = (j == x) ? c : mine; }
        if (sum == G) break;
        __builtin_amdgcn_s_sleep(1);
        if ((++sp & 255u) == 0u) { if (xb_ld(&bar[XB_TMO])) break; if (sp > XB_SPIN_CAP) { atomicAdd(&bar[XB_TMO], 1u); break; } }
    }
    nloc = mine > 0u ? mine : 1u; nx = cnt > 0u ? cnt : 1u;
}
__device__ __forceinline__ void xcd_barrier(const XcdBarrier& b) {
    asm volatile("s_waitcnt vmcnt(0)" ::: "memory");
    __syncthreads();
    if (threadIdx.x == 0) {
        unsigned* bar = b.bar;
        __builtin_amdgcn_s_waitcnt(0);
        unsigned nloc = b.st[0], nx = b.st[1];
        if (nloc == 0u) { xcd_barrier_complete(bar, b.x, nloc, nx); b.st[0] = nloc; b.st[1] = nx; }
        const unsigned old = xb_add(&bar[XB_XSUB(b.x)], 1u);
        const unsigned gen = old / nloc;
        if (old + 1u == (gen + 1u) * nloc) {
            __builtin_amdgcn_fence(__ATOMIC_RELEASE, "agent");
            asm volatile("s_waitcnt vmcnt(0)" ::: "memory");
            const unsigned og = xb_add(&bar[XB_TOP], 1u);
            asm volatile("buffer_inv sc1" ::: "memory");
            const unsigned target = (og / nx + 1u) * nx;
            if (og + 1u != target) XB_SPIN(xb_ld(&bar[XB_TOP]) < target, bar);
            xb_add(&bar[XB_XGEN(b.x)], 1u);
            asm volatile("s_waitcnt vmcnt(0)" ::: "memory");
        } else {
            asm volatile("buffer_inv sc1" ::: "memory");
            XB_SPIN(xb_ld(&bar[XB_XGEN(b.x)]) == gen, bar);
            asm volatile("s_waitcnt vmcnt(0)" ::: "memory");
        }
    }
    __syncthreads();
}

constexpr int RING_BYTES = 131072, LDSCTL_OFF = RING_BYTES, MISC_OFF = LDSCTL_OFF + 320, LDS_BYTES = 147456;
struct Args { const float* in[21]; float* out; unsigned char* ws; int ph_lo, ph_hi; };
struct Frame {
    LAS unsigned char* lds;
    int tid, lane, wave, vcu, G;
    const Args& a;
    __device__ __forceinline__ Frame(const Args& a_) : a(a_) {}
    __device__ __forceinline__ const float* x() const { return a.in[0]; }
    __device__ __forceinline__ const float* mem() const { return a.in[1]; }
    __device__ __forceinline__ const float* g_mix() const { return a.in[2]; }
    __device__ __forceinline__ const float* w_in() const { return a.in[3]; }
    __device__ __forceinline__ const float* w_conv() const { return a.in[4]; }
    __device__ __forceinline__ const float* g_conv() const { return a.in[5]; }
    __device__ __forceinline__ const float* g_sb() const { return a.in[6]; }
    __device__ __forceinline__ const float* w_out() const { return a.in[7]; }
    __device__ __forceinline__ const float* g_xattn() const { return a.in[8]; }
    __device__ __forceinline__ const float* g_mem() const { return a.in[9]; }
    __device__ __forceinline__ const float* w_xq() const { return a.in[10]; }
    __device__ __forceinline__ const float* w_xkv() const { return a.in[11]; }
    __device__ __forceinline__ const float* w_xo() const { return a.in[12]; }
    __device__ __forceinline__ const float* g_ffn() const { return a.in[13]; }
    __device__ __forceinline__ const float* w_router() const { return a.in[14]; }
    __device__ __forceinline__ const float* b_router() const { return a.in[15]; }
    __device__ __forceinline__ const float* w_gu() const { return a.in[16]; }
    __device__ __forceinline__ const float* b_gu() const { return a.in[17]; }
    __device__ __forceinline__ const float* w_down() const { return a.in[18]; }
    __device__ __forceinline__ const float* b_down() const { return a.in[19]; }
    __device__ __forceinline__ const float* g_final() const { return a.in[20]; }
    __device__ __forceinline__ float* out() const { return a.out; }
    __device__ __forceinline__ int* LTOK() const { return (int*)(a.ws + WS_XG); }
    __device__ __forceinline__ float* LGATE() const { return (float*)(a.ws + WS_XG + 2 * MiB); }
    __device__ __forceinline__ unsigned char* XB8() const { return a.ws + WS_XG + 4 * MiB; }
    __device__ __forceinline__ bf16* X2B() const { return (bf16*)(a.ws + WS_XG + 40 * MiB); }
    __device__ __forceinline__ unsigned char* Mt8() const { return a.ws + WS_QX; }
    __device__ __forceinline__ unsigned char* Vt8() const { return a.ws + WS_QX + 8 * MiB; }
    __device__ __forceinline__ bf16* WrT() const { return (bf16*)(a.ws + WS_QX + 20 * MiB); }
    __device__ __forceinline__ bf16* WxqB() const { return (bf16*)(a.ws + WS_QX + 16 * MiB); }
    __device__ __forceinline__ bf16* WinT() const { return (bf16*)(a.ws + WS_WIN); }
    __device__ __forceinline__ bf16* WoutT() const { return (bf16*)(a.ws + WS_WOUT); }
    __device__ __forceinline__ bf16* WxqT() const { return (bf16*)(a.ws + WS_WXQ); }
    __device__ __forceinline__ bf16* WxkvT() const { return (bf16*)(a.ws + WS_WXKV); }
    __device__ __forceinline__ bf16* WxoT() const { return (bf16*)(a.ws + WS_WXO); }
    __device__ __forceinline__ unsigned char* WguT8() const { return a.ws + WS_WGU; }
    __device__ __forceinline__ unsigned char* WdT8() const { return a.ws + WS_WD; }
    __device__ __forceinline__ bf16* XN() const { return (bf16*)(a.ws + WS_XN); }
    __device__ __forceinline__ bf16* MN() const { return (bf16*)(a.ws + WS_MN); }
    __device__ __forceinline__ bf16* PROJ() const { return (bf16*)(a.ws + WS_PROJ); }
    __device__ __forceinline__ bf16* YMIX() const { return (bf16*)(a.ws + WS_YMIX); }
    __device__ __forceinline__ bf16* XA() const { return (bf16*)(a.ws + WS_XA); }
    __device__ __forceinline__ unsigned char* XA8() const { return a.ws + WS_OX; }
    __device__ __forceinline__ bf16* KVX() const { return (bf16*)(a.ws + WS_KVX); }
    __device__ __forceinline__ unsigned char* PX8() const { return a.ws + WS_PX; }
    __device__ __forceinline__ bf16* XG() const { return (bf16*)(a.ws + WS_XG); }
    __device__ __forceinline__ unsigned char* ACT8() const { return a.ws + WS_ACT; }
    __device__ __forceinline__ bf16* Y() const { return (bf16*)(a.ws + WS_Y); }
    __device__ __forceinline__ float* SSP1() const { return (float*)(a.ws + WS_MISC + MS_SSP1); }
    __device__ __forceinline__ float* RGATE() const { return (float*)(a.ws + WS_MISC + MS_RGATE); }
    __device__ __forceinline__ int* TOPI() const { return (int*)(a.ws + WS_MISC + MS_TOPI); }
    __device__ __forceinline__ int* SLOT() const { return (int*)(a.ws + WS_MISC + MS_SLOT); }
    __device__ __forceinline__ int* RTOK() const { return (int*)(a.ws + WS_MISC + MS_RTOK); }
    __device__ __forceinline__ int* TEXP() const { return (int*)(a.ws + WS_MISC + MS_TEXP); }
    __device__ __forceinline__ int* NT() const { return (int*)(a.ws + WS_MISC + MS_NT); }
};

typedef float f32x2_t __attribute__((ext_vector_type(2))); typedef __bf16 bf16x2_t __attribute__((ext_vector_type(2)));
__device__ __forceinline__ unsigned cvtpk_hw(float lo, float hi) { f32x2_t v = {lo, hi}; bf16x2_t b = __builtin_convertvector(v, bf16x2_t); return __builtin_bit_cast(unsigned, b); }
struct TrItem { const float* wp; const LAS float* g; bf16* wt; int N; int k0; unsigned char* wt8; };
__device__ __forceinline__ void tr_load(const TrItem& it, int half, f32x4 (&va)[8], f32x4 (&vb)[8]) {
#pragma unroll
    for (int j = 0; j < 8; ++j) { const float* p = it.wp + (size_t)(half * 64 + 8 * j) * it.N; va[j] = __builtin_nontemporal_load((const f32x4*)p); vb[j] = __builtin_nontemporal_load((const f32x4*)(p + it.N)); }
}
__device__ __forceinline__ void tr_pack(const TrItem& it, int half, const f32x4 (&va)[8], const f32x4 (&vb)[8], LAS unsigned* T, int lane) {
    const int pr = lane >> 4, nc = lane & 15;
#pragma unroll
    for (int j = 0; j < 8; ++j) { const int pp = half * 32 + 4 * j + pr; const float ga = it.g[it.k0 + 2 * pp], gb = it.g[it.k0 + 2 * pp + 1];
        const int c = half * 8 + j;
#pragma unroll
        for (int i = 0; i < 4; ++i) T[(4 * nc + i) * 64 + ((c ^ (nc & 7)) * 4 + pr)] = cvtpk_hw(va[j][i] * ga, vb[j][i] * gb); }
}
__device__ __forceinline__ void tr_store(const TrItem& it, LAS unsigned* T, int lane) {
    LDS_WAIT(); asm volatile("" ::: "memory");
    const int pr = lane >> 4, c = lane & 15;
#pragma unroll
    for (int jj = 0; jj < 16; ++jj) { const int n = 4 * jj + pr; const v4u o = *(const LAS v4u*)(T + n * 64 + ((c ^ (jj & 7)) * 4));
        *(v4u*)(it.wt + (size_t)n * D + 8 * c) = o; }
    LDS_WAIT(); asm volatile("" ::: "memory");
}
constexpr float XASCALE = 16.f, MVSCALE = 32.f, PSCALE = 256.f;
constexpr float F8MAX = 448.f, WSCALE = 256.f, XSCALE = 16.f, ASCALE = 8.f;
__device__ __forceinline__ unsigned pk4_fp8(float a, float b, float c, float d) {
    a = __builtin_amdgcn_fmed3f(a, -F8MAX, F8MAX); b = __builtin_amdgcn_fmed3f(b, -F8MAX, F8MAX); c = __builtin_amdgcn_fmed3f(c, -F8MAX, F8MAX); d = __builtin_amdgcn_fmed3f(d, -F8MAX, F8MAX);
    int t = __builtin_amdgcn_cvt_pk_fp8_f32(a, b, 0, false); t = __builtin_amdgcn_cvt_pk_fp8_f32(c, d, t, true); return (unsigned)t; }
__device__ __forceinline__ void tr8_load(const TrItem& it, int half, f32x4 (&v)[16]) {
#pragma unroll
    for (int j = 0; j < 4; ++j)
#pragma unroll
        for (int q = 0; q < 4; ++q) v[4 * j + q] = __builtin_nontemporal_load((const f32x4*)(it.wp + (size_t)(half * 64 + 16 * j + q) * it.N));
}
template <bool NOGAIN = false>
__device__ __forceinline__ void tr8_pack(const TrItem& it, int half, const f32x4 (&v)[16], LAS unsigned* T, int lane) {
    const int pr = lane >> 4, nc = lane & 15;
#pragma unroll
    for (int j = 0; j < 4; ++j) { const LAS float* gp = it.g + it.k0 + half * 64 + 16 * j + 4 * pr;
        const float g0 = NOGAIN ? WSCALE : gp[0] * WSCALE, g1 = NOGAIN ? WSCALE : gp[1] * WSCALE, g2 = NOGAIN ? WSCALE : gp[2] * WSCALE, g3 = NOGAIN ? WSCALE : gp[3] * WSCALE; const int c = half * 4 + j;
#pragma unroll
        for (int i = 0; i < 4; ++i) T[(4 * nc + i) * 32 + ((c ^ (nc & 7)) * 4 + pr)] = pk4_fp8(v[4 * j][i] * g0, v[4 * j + 1][i] * g1, v[4 * j + 2][i] * g2, v[4 * j + 3][i] * g3); }
}
__device__ __forceinline__ void tr8_store(const TrItem& it, LAS unsigned* T, int lane) {
    LDS_WAIT(); asm volatile("" ::: "memory");
    const int rr = lane >> 3, c = lane & 7;
#pragma unroll
    for (int jj = 0; jj < 8; ++jj) { const int n = 8 * jj + rr; const v4u o = *(const LAS v4u*)(T + n * 32 + ((c ^ ((n >> 2) & 7)) * 4));
        *(v4u*)(it.wt8 + (size_t)n * D + 16 * c) = o; }
    LDS_WAIT(); asm volatile("" ::: "memory");
}
template <int NR>
__device__ __forceinline__ void rms_rows_to_bf16(const float* xrow, const float* g, bf16* orow, int lane) {
    f32x4 v[NR][4];
#pragma unroll
    for (int r = 0; r < NR; ++r)
#pragma unroll
        for (int j = 0; j < 4; ++j) v[r][j] = __builtin_nontemporal_load((const f32x4*)(xrow + (size_t)r * D) + lane + 64 * j);
    const f32x4* gr = (const f32x4*)g + lane;
#pragma unroll
    for (int r = 0; r < NR; ++r) { float s = 0.f;
#pragma unroll
        for (int j = 0; j < 4; ++j) s += (v[r][j].x * v[r][j].x + v[r][j].y * v[r][j].y) + (v[r][j].z * v[r][j].z + v[r][j].w * v[r][j].w);
        const float rstd = 1.f / sqrtf(wave_sum(s) * (1.f / D) + EPS);
        unsigned long long* o8 = (unsigned long long*)(orow + (size_t)r * D) + lane;
#pragma unroll
        for (int j = 0; j < 4; ++j) { const f32x4 gg = gr[64 * j];
            o8[64 * j] = (unsigned long long)pk2(v[r][j].x * rstd * gg.x, v[r][j].y * rstd * gg.y) | ((unsigned long long)pk2(v[r][j].z * rstd * gg.z, v[r][j].w * rstd * gg.w) << 32); } }
}
constexpr int I_IN = 8 * 48, I_SQ = 8 * 16, I_KV = 8 * 32, I_GU1 = 8 * 32, I_GU = NE * I_GU1, I_D1 = 8 * 16, I_DN = NE * I_D1;
constexpr int I_MOE = I_GU + I_DN, NITEMS = I_MOE + I_IN + 3 * I_SQ + I_KV;
static_assert(I_MOE == 12288 && NITEMS - I_MOE == 1024, "work split assumes 2048 waves: one non-expert item for waves < 1024 in the prologue");
constexpr int I_P1 = 96 * NWAVES * 14;
constexpr int GT_OFF = 132096;
__device__ __forceinline__ void tr_tables(Frame& F) {
    LAS float* gt = (LAS float*)(F.lds + GT_OFF);
    for (int k = F.tid; k < D; k += NWAVES * 64) { gt[k] = 1.f; gt[D + k] = F.g_ffn()[k]; gt[2 * D + k] = F.g_xattn()[k]; }
    __syncthreads();
}
template <bool F8>
__device__ __forceinline__ TrItem tr_decode(Frame& F, int item) {
    int r = item; const float* W; bf16* WT = nullptr; unsigned char* WT8 = nullptr; int gsel = 0; int N = D;
    if (r < I_GU) { const int e = r / I_GU1; W = F.w_gu() + (size_t)e * D * NGU; WT8 = F.WguT8() + (size_t)e * NGU * D; gsel = 1; N = NGU; r %= I_GU1; }
    else if ((r -= I_GU) < I_DN) { const int e = r / I_D1; W = F.w_down() + (size_t)e * D * D; WT8 = F.WdT8() + (size_t)e * D * D; r %= I_D1; }
    else if ((r -= I_DN) < I_IN) { W = F.w_in(); WT = F.WinT(); N = NPROJ; }
    else if ((r -= I_IN) < I_SQ) { W = F.w_out(); WT = F.WoutT(); }
    else if ((r -= I_SQ) < I_SQ) { W = F.w_xq(); WT = F.WxqT(); gsel = 2; }
    else if ((r -= I_SQ) < I_KV) { W = F.w_xkv(); WT = F.WxkvT(); N = 2 * D; }
    else { r -= I_KV; W = F.w_xo(); WT = F.WxoT(); }
    const int nblk = N / 64, kb = r / nblk, nb = r % nblk, k0 = 128 * kb, n0 = 64 * nb;
    TrItem t; t.N = N; t.k0 = k0; t.g = (const LAS float*)(F.lds + GT_OFF) + gsel * D; t.wp = W + (size_t)(k0 + (F8 ? 4 : 2) * (F.lane >> 4)) * N + n0 + 4 * (F.lane & 15);
    t.wt = F8 ? nullptr : WT + (size_t)n0 * D + k0; t.wt8 = F8 ? WT8 + (size_t)n0 * D + k0 : nullptr; return t;
}
template <bool F8, bool NOGAIN = false, bool TABLES = false>
__device__ __forceinline__ void tr_run(Frame& F, int first, int stride, int last, LAS unsigned* scr) {
    if (first >= last) return;
    int item = first; TrItem cur = tr_decode<F8>(F, item), nxt = cur;
    if constexpr (F8) {
        f32x4 v0[16], v1[16]; TrItem prev = cur; int par = 0;
        auto LD1 = [&]() { tr8_load(cur, 1, v1); };
        auto ST = [&]() { tr8_store(prev, scr + (par ^ 1) * 2048, F.lane); };
        auto PK0 = [&]() { tr8_pack<NOGAIN>(cur, 0, v0, scr + par * 2048, F.lane); };
        auto PK1 = [&]() { tr8_pack<NOGAIN>(cur, 1, v1, scr + par * 2048, F.lane); };
        auto NX = [&]() { nxt = tr_decode<F8>(F, item + stride); tr8_load(nxt, 0, v0); };
        auto ADV = [&]() { prev = cur; cur = nxt; item += stride; par ^= 1; };
        tr8_load(cur, 0, v0);
        if (item + stride < last) {
            LD1(); if (TABLES) tr_tables(F); PK0(); NX(); PK1(); ADV();
            while (item + stride < last) { LD1(); ST(); PK0(); NX(); PK1(); ADV(); }
            LD1(); ST(); PK0(); PK1(); prev = cur; par ^= 1; ST();
        } else { LD1(); if (TABLES) tr_tables(F); PK0(); PK1(); prev = cur; par ^= 1; ST(); }
    } else {
        f32x4 a0[8], b0[8], a1[8], b1[8];
        tr_load(cur, 0, a0, b0);
        for (;;) {
            tr_load(cur, 1, a1, b1);
            tr_pack(cur, 0, a0, b0, scr, F.lane);
            const bool has_next = item + stride < last;
            if (has_next) { nxt = tr_decode<F8>(F, item + stride); tr_load(nxt, 0, a0, b0); }
            tr_pack(cur, 1, a1, b1, scr, F.lane);
            tr_store(cur, scr, F.lane);
            if (!has_next) break;
            cur = nxt; item += stride;
        }
    }
}
__device__ __forceinline__ void p0_prologue(Frame& F) {
    LAS unsigned* scr = (LAS unsigned*)(F.lds + F.wave * 16384);
    const int gw = F.vcu * NWAVES + F.wave, NGW = F.G * NWAVES;
    if (NGW == 2048) {
        if (gw < NITEMS - I_MOE) { const TrItem it = tr_decode<false>(F, I_MOE + gw); f32x4 a0[8], b0[8], a1[8], b1[8];
            tr_load(it, 0, a0, b0); tr_load(it, 1, a1, b1);
            tr_tables(F);
            tr_pack(it, 0, a0, b0, scr, F.lane); tr_pack(it, 1, a1, b1, scr, F.lane); tr_store(it, scr, F.lane); }
    } else { tr_tables(F); tr_run<false>(F, I_MOE + gw, NGW, NITEMS, scr); }
    if (NGW == 2048) {
        if (gw < 1024) { rms_rows_to_bf16<4>(F.x() + (size_t)(gw * 4) * D, F.g_mix(), F.XN() + (size_t)(gw * 4) * D, F.lane);
                         rms_rows_to_bf16<1>(F.mem() + (size_t)gw * D, F.g_mem(), F.MN() + (size_t)gw * D, F.lane); }
        else { const int m0 = 4096 + (gw - 1024) * 12;
#pragma unroll 1
               for (int j = 0; j < 3; ++j) rms_rows_to_bf16<4>(F.x() + (size_t)(m0 + 4 * j) * D, F.g_mix(), F.XN() + (size_t)(m0 + 4 * j) * D, F.lane); }
        if (gw >= NGW - 64) { const int n = (gw - (NGW - 64)) & 31, part = (gw - (NGW - 64)) >> 5;
            for (int i = 0; i < 8; ++i) { const int k = part * 512 + F.lane + 64 * i; const float v = F.g_ffn()[k] * F.w_router()[(size_t)k * NE + n];
                const unsigned hi = f2bf(v); const float rem = v - bf2f(hi); const size_t fo = ((size_t)(((k >> 8) * 16 + ((k >> 4) & 15)) * 2) * 64 + ((k >> 3) & 1) * 32 + n) * 8 + (k & 7);
                F.WrT()[fo] = (bf16)hi; F.WrT()[fo + 64 * 8] = (bf16)f2bf(rem); } }
        if (gw >= 1024) { const int c = gw - 1024; const float gc = F.g_xattn()[c];
            const f32x4* wr = (const f32x4*)(F.w_xq() + (size_t)c * D) + F.lane; unsigned long long* o8 = (unsigned long long*)(F.WxqB() + (size_t)c * D) + F.lane;
#pragma unroll
            for (int j = 0; j < 4; ++j) { const f32x4 v = wr[64 * j] * gc; o8[64 * j] = (unsigned long long)pk2(v.x, v.y) | ((unsigned long long)pk2(v.z, v.w) << 32); } }
    } else {
        for (int m = gw * 4; m < NTOK; m += NGW * 4) rms_rows_to_bf16<4>(F.x() + (size_t)m * D, F.g_mix(), F.XN() + (size_t)m * D, F.lane);
        for (int m = gw; m < NMEM; m += NGW) rms_rows_to_bf16<1>(F.mem() + (size_t)m * D, F.g_mem(), F.MN() + (size_t)m * D, F.lane);
    }
}

namespace pg8 {
typedef short bf16x8 __attribute__((ext_vector_type(8)));
constexpr int BM = 256, BK = 64, HALF = 128, HTB = HALF * BK * 2, STAGE_BYTES = 8 * HTB, NXCD = 8, WGM = 8;
__host__ __device__ __forceinline__ int lds_byte(int r, int c) { const int st = (r >> 4) * 2 + (c >> 5), rr = r & 15, cc = c & 31, ob = rr * 64 + cc * 2; return st * 1024 + (ob ^ (((ob >> 9) & 1) << 5)); }
__host__ __device__ __forceinline__ void stage_rc(int b, int& R, int& C) { const int st = b / 1024, sb = b % 1024, swz = sb ^ (((sb >> 9) & 1) << 5); R = (st >> 1) * 16 + swz / 64; C = (st & 1) * 32 + (swz % 64) / 2; }
__host__ __device__ __forceinline__ int perm16(int R) { return 64 * (R >> 5) + 16 * ((R >> 2) & 3) + 4 * ((R >> 4) & 1) + (R & 3); }
__host__ __device__ __forceinline__ int perm32(int rho) { const int n = rho >> 4, i = rho & 15; return 8 * (i >> 2) + 4 * n + (i & 3); }
struct Unit { int pm, pn, aux; long a_off, b_off; };
struct Gemm { const bf16* A; const bf16* Bt; int lda, ldb, K; const LAS int* gl; };
struct StaticOrder {
    int nM, nN, nwg, G, c, lda, ldb, wgm; const LAS int* texp;
    __device__ void init(int nM_, int nN_, int G_, int c_, int lda_, int ldb_, const LAS int* texp_, int wgm_ = WGM) { nM = nM_; nN = nN_; nwg = nM * nN; G = G_; c = c_; lda = lda_; ldb = ldb_; texp = texp_; wgm = wgm_; }
    __device__ bool next(int i, Unit& u) const {
        const long L = (long)i * G + c; if (L >= nwg) return false;
        int wgid = (int)L; { const int q = nwg / NXCD, r = nwg % NXCD, xcd = wgid % NXCD, off = wgid / NXCD; wgid = (xcd < r ? xcd * (q + 1) : r * (q + 1) + (xcd - r) * q) + off; }
        const int nig = wgm * nN, gid = wgid / nig, fm = gid * wgm, gsz = (nM - fm) < wgm ? (nM - fm) : wgm;
        u.pm = fm + ((wgid % nig) % gsz); u.pn = (wgid % nig) / gsz;
        u.aux = texp ? texp[u.pm] : 0;
        u.a_off = (long)u.pm * BM * lda; u.b_off = ((long)u.aux * nN + u.pn) * BM * ldb; return true;
    }
};
struct OneUnit { Unit u0; __device__ bool next(int i, Unit& u) const { if (i > 0) return false; u = u0; return true; } };

__device__ __forceinline__ unsigned cvt_pk_bf16(float lo, float hi) { unsigned r; asm volatile("v_cvt_pk_bf16_f32 %0, %1, %2" : "=v"(r) : "v"(lo), "v"(hi)); return r; }

typedef int v8i_t __attribute__((ext_vector_type(8))); typedef int v4i_t __attribute__((ext_vector_type(4)));
__device__ __forceinline__ f32x4 mma_fp8(bf16x8 b0, bf16x8 b1, bf16x8 a0, bf16x8 a1, f32x4 c) {
    const v4i_t x0 = __builtin_bit_cast(v4i_t, b0), x1 = __builtin_bit_cast(v4i_t, b1), y0 = __builtin_bit_cast(v4i_t, a0), y1 = __builtin_bit_cast(v4i_t, a1);
    const v8i_t X = __builtin_shufflevector(x0, x1, 0, 1, 2, 3, 4, 5, 6, 7), Y = __builtin_shufflevector(y0, y1, 0, 1, 2, 3, 4, 5, 6, 7);
    asm volatile("v_mfma_f32_16x16x128_f8f6f4 %0, %1, %2, %0" : "+v"(c) : "v"(X), "v"(Y));
    return c; }
#define MMA_FP8_DRAIN() asm volatile("s_nop 15\n\ts_nop 15" ::: "memory")
template <class Epi, class Sched, bool ALIGN_EPI, bool F8 = false>
__device__ __forceinline__ void gemm_phase(LAS unsigned char* lds, const Gemm g, const Sched& S, const Epi& E) {
    const int tid = threadIdx.x, wid = __builtin_amdgcn_readfirstlane(tid >> 6), lane = tid & 63, wr = wid >> 2, wc = wid & 3, fr = lane & 15, fq = lane >> 4;
    const int K = g.K, nt = K / BK;
    unsigned voffB[2]; int RA[2], CA[2];
#pragma unroll
    for (int i = 0; i < 2; ++i) { int R, C; stage_rc(tid * 16 + i * 8192, R, C); const int Rb = Epi::PERM16 ? perm16(R) : Epi::PERM ? ((R & ~31) + perm32(R & 31)) : R;
        RA[i] = R; CA[i] = C; voffB[i] = (unsigned)(Rb * g.ldb + C) * 2u; }
#define PG8_AOFF(vo, ui_) do { _Pragma("unroll") for (int h_ = 0; h_ < 2; ++h_) _Pragma("unroll") for (int i_ = 0; i_ < 2; ++i_) { \
        const int row_ = g.gl ? g.gl[(ui_) * BM + h_ * HALF + RA[i_]] : (h_ * HALF + RA[i_]); vo[h_][i_] = (unsigned)(row_ * g.lda + CA[i_]) * 2u; } } while (0)
    const size_t kstep = (size_t)(BK * 2);
    const size_t hstepB = (size_t)(Epi::PERM16 ? 8 : HALF) * g.ldb * 2;
    const unsigned ldsw = (unsigned)wid * 1024u;
    const int aoff = lds_byte(wr * 64 + fr, fq * 8), boff = lds_byte(wc * 32 + fr, fq * 8);
#define PG8_SA(b, h) (((b) * 2 + (h)) * HTB)
#define PG8_SB(b, h) ((4 + (b) * 2 + (h)) * HTB)
#define PG8_STAGE(bufoff, gbase, voff) do { _Pragma("unroll") for (int _i = 0; _i < 2; ++_i) { unsigned vo_ = (voff)[_i]; if constexpr (F8) asm volatile("" : "+v"(vo_));     \
        __builtin_amdgcn_global_load_lds((const unsigned*)((const char*)(gbase) + vo_), (LAS unsigned*)(lds + (bufoff) + ldsw + _i * 8192), 16, 0, 0); } } while (0)
#define PG8_LDA(dst, b, h) do { _Pragma("unroll") for (int m = 0; m < 4; ++m) _Pragma("unroll") for (int k = 0; k < 2; ++k) dst[m][k] = *(const LAS bf16x8*)(lds + PG8_SA(b, h) + aoff + m * 2048 + k * 1024); } while (0)
#define PG8_LDB(dst, b, h) do { _Pragma("unroll") for (int n = 0; n < 2; ++n) _Pragma("unroll") for (int k = 0; k < 2; ++k) dst[n][k] = *(const LAS bf16x8*)(lds + PG8_SB(b, h) + boff + n * 2048 + k * 1024); } while (0)
#define PG8_MMA(ai, bj, At, Bt) do { __builtin_amdgcn_s_setprio(1); _Pragma("unroll") for (int m = 0; m < 4; ++m) _Pragma("unroll") for (int n = 0; n < 2; ++n) { \
        if constexpr (F8) acc[ai][bj][m][n] = mma_fp8(Bt[n][0], Bt[n][1], At[m][0], At[m][1], acc[ai][bj][m][n]); \
        else { _Pragma("unroll") for (int k = 0; k < 2; ++k) acc[ai][bj][m][n] = __builtin_amdgcn_mfma_f32_16x16x32_bf16(Bt[n][k], At[m][k], acc[ai][bj][m][n], 0, 0, 0); } } \
        __builtin_amdgcn_s_setprio(0); } while (0)
#define PG8_WAIT_V(n) asm volatile("s_waitcnt vmcnt(" #n ")" ::: "memory")
#define PG8_WAIT_L(n) asm volatile("s_waitcnt lgkmcnt(" #n ")" ::: "memory")
#define PG8_BAR __builtin_amdgcn_s_barrier()
#define PG8_SCHED __builtin_amdgcn_sched_barrier(0)
    Unit cur, nxt; int ui = 0;
    if (!S.next(0, cur)) return;
    f32x4 acc[2][2][4][2];
#pragma unroll
    for (int a = 0; a < 2; ++a)
#pragma unroll
        for (int b = 0; b < 2; ++b)
#pragma unroll
            for (int m = 0; m < 4; ++m)
#pragma unroll
                for (int n = 0; n < 2; ++n) acc[a][b][m][n] = (f32x4){0.f, 0.f, 0.f, 0.f};
    bf16x8 At[4][2], B0[2][2], B1[2][2];
    const char* cA = (const char*)(g.A + (g.gl ? 0 : cur.a_off)); const char* cB = (const char*)(g.Bt + cur.b_off);
    unsigned vAc[2][2], vAn[2][2];
    PG8_AOFF(vAc, 0);
    PG8_STAGE(PG8_SB(0, 0), cB, voffB); PG8_STAGE(PG8_SB(0, 1), cB + hstepB, voffB); PG8_STAGE(PG8_SA(0, 0), cA, vAc[0]); PG8_STAGE(PG8_SA(0, 1), cA, vAc[1]);
    if (wr == 1) PG8_BAR;
    PG8_WAIT_V(2); PG8_BAR;
    PG8_STAGE(PG8_SB(1, 0), cB + kstep, voffB); PG8_STAGE(PG8_SA(1, 0), cA + kstep, vAc[0]); PG8_STAGE(PG8_SB(1, 1), cB + hstepB + kstep, voffB);
    PG8_WAIT_V(6); PG8_BAR;
    for (;;) {
        const bool has_next = S.next(ui + 1, nxt);
        const char* nA = has_next ? (const char*)(g.A + (g.gl ? 0 : nxt.a_off)) : cA; const char* nB = has_next ? (const char*)(g.Bt + nxt.b_off) : cB;
        if (has_next) PG8_AOFF(vAn, ui + 1); else {
#pragma unroll
            for (int h_ = 0; h_ < 2; ++h_)
#pragma unroll
                for (int i_ = 0; i_ < 2; ++i_) vAn[h_][i_] = vAc[h_][i_]; }
#pragma unroll 1
        for (int t = 0; t < nt; t += 2) {
            const bool last = (t == nt - 2);
            const char* a1 = cA + (size_t)(t + 1) * kstep;
            const char* a2 = last ? nA : cA + (size_t)(t + 2) * kstep; const char* b2 = last ? nB : cB + (size_t)(t + 2) * kstep;
            const char* a3 = a2 + kstep; const char* b3 = b2 + kstep;
            unsigned v2[2][2];
#pragma unroll
            for (int h_ = 0; h_ < 2; ++h_)
#pragma unroll
                for (int i_ = 0; i_ < 2; ++i_) v2[h_][i_] = last ? vAn[h_][i_] : vAc[h_][i_];
            PG8_LDB(B0, 0, 0); PG8_LDB(B1, 0, 1); PG8_SCHED; PG8_LDA(At, 0, 0); PG8_STAGE(PG8_SA(1, 1), a1, vAc[1]);
            PG8_WAIT_V(8); PG8_WAIT_L(0); PG8_BAR; PG8_MMA(0, 0, At, B0); PG8_MMA(0, 1, At, B1); PG8_BAR; PG8_SCHED;
            PG8_LDA(At, 0, 1); PG8_STAGE(PG8_SB(0, 0), b2, voffB); PG8_STAGE(PG8_SB(0, 1), b2 + hstepB, voffB); PG8_STAGE(PG8_SA(0, 0), a2, v2[0]);
            PG8_WAIT_V(8); PG8_WAIT_L(0); PG8_BAR; PG8_MMA(1, 0, At, B0); PG8_MMA(1, 1, At, B1); PG8_BAR; PG8_SCHED;
            PG8_LDB(B0, 1, 0); PG8_LDB(B1, 1, 1); PG8_SCHED; PG8_LDA(At, 1, 0); PG8_STAGE(PG8_SA(0, 1), a2, v2[1]);
            PG8_WAIT_V(8); PG8_WAIT_L(0); PG8_BAR; PG8_MMA(0, 0, At, B0); PG8_MMA(0, 1, At, B1); PG8_BAR; PG8_SCHED;
            PG8_LDA(At, 1, 1); PG8_STAGE(PG8_SB(1, 0), b3, voffB); PG8_STAGE(PG8_SB(1, 1), b3 + hstepB, voffB); PG8_STAGE(PG8_SA(1, 0), a3, v2[0]);
            PG8_WAIT_V(8); PG8_WAIT_L(0); PG8_BAR; PG8_MMA(1, 0, At, B0); PG8_MMA(1, 1, At, B1); PG8_BAR; PG8_SCHED;
        }
        if constexpr (F8) MMA_FP8_DRAIN();
        if constexpr (ALIGN_EPI) { if (wr == 0) PG8_BAR; }
        if constexpr (!Epi::AFTER_DRAIN) { E(acc, cur, wr, wc, fr, fq); }
        if (!has_next) break;
#pragma unroll
        for (int a = 0; a < 2; ++a)
#pragma unroll
            for (int b = 0; b < 2; ++b)
#pragma unroll
                for (int m = 0; m < 4; ++m)
#pragma unroll
                    for (int n = 0; n < 2; ++n) acc[a][b][m][n] = (f32x4){0.f, 0.f, 0.f, 0.f};
        cur = nxt; cA = nA; cB = nB; ++ui;
#pragma unroll
        for (int h_ = 0; h_ < 2; ++h_)
#pragma unroll
            for (int i_ = 0; i_ < 2; ++i_) vAc[h_][i_] = vAn[h_][i_];
        if constexpr (ALIGN_EPI) { if (wr == 1) PG8_BAR; }
    }
    PG8_WAIT_V(0);
    if constexpr (!ALIGN_EPI) { if (wr == 0) PG8_BAR; }
    PG8_BAR;
    if constexpr (Epi::AFTER_DRAIN) { E.fused(acc, cur, wr, wc, fr, fq, lds, wid, lane); }
#undef PG8_AOFF
#undef PG8_SA
#undef PG8_SB
#undef PG8_STAGE
#undef PG8_LDA
#undef PG8_LDB
#undef PG8_MMA
#undef PG8_WAIT_V
#undef PG8_WAIT_L
#undef PG8_BAR
#undef PG8_SCHED
}

typedef float f32x2 __attribute__((ext_vector_type(2)));
#define EPI_LOOP_AI_M _Pragma("unroll") for (int ai = 0; ai < 2; ++ai) _Pragma("unroll") for (int m = 0; m < 4; ++m)
struct EpiBf16 {
    static constexpr bool PERM = true, AFTER_DRAIN = false, PERM16 = false;
    bf16* O; int ldc; int pn_lo, pn_hi; float scale;
    __device__ __forceinline__ void operator()(const f32x4 (&acc)[2][2][4][2], const Unit& u, int wr, int wc, int fr, int fq) const {
        const float sc = (u.pn >= pn_lo && u.pn < pn_hi) ? scale : 1.f;
        const int row0 = u.pm * BM + wr * 64 + fr, col0 = u.pn * BM + wc * 32 + 8 * fq;
        EPI_LOOP_AI_M { bf16* rowp = O + (size_t)(row0 + ai * HALF + m * 16) * ldc + col0;
#pragma unroll
            for (int bj = 0; bj < 2; ++bj) { const f32x4 v0 = acc[ai][bj][m][0] * sc, v1 = acc[ai][bj][m][1] * sc;
                v4u w; w.x = cvt_pk_bf16(v0[0], v0[1]); w.y = cvt_pk_bf16(v0[2], v0[3]); w.z = cvt_pk_bf16(v1[0], v1[1]); w.w = cvt_pk_bf16(v1[2], v1[3]);
                *(v4u*)(rowp + bj * HALF) = w; } }
    }
};
struct EpiKV {
    static constexpr bool PERM = true, AFTER_DRAIN = false, PERM16 = false;
    bf16* O;
    __device__ __forceinline__ void operator()(const f32x4 (&acc)[2][2][4][2], const Unit& u, int wr, int wc, int fr, int fq) const {
        const int row0 = u.pm * BM + wr * 64 + fr, col0 = u.pn * BM + wc * 32 + 8 * fq;
        EPI_LOOP_AI_M { bf16* rowp = O + (size_t)(row0 + ai * HALF + m * 16) * (2 * D) + col0;
#pragma unroll
            for (int bj = 0; bj < 2; ++bj) { const f32x4 v0 = acc[ai][bj][m][0], v1 = acc[ai][bj][m][1];
                v4u w; w.x = cvt_pk_bf16(v0[0], v0[1]); w.y = cvt_pk_bf16(v0[2], v0[3]); w.z = cvt_pk_bf16(v1[0], v1[1]); w.w = cvt_pk_bf16(v1[2], v1[3]);
                *(v4u*)(rowp + bj * HALF) = w; } }
    }
};
struct EpiF8 {
    static constexpr bool PERM = true, AFTER_DRAIN = false, PERM16 = false;
    unsigned char* O; int ldc; float scale;
    __device__ __forceinline__ void operator()(const f32x4 (&acc)[2][2][4][2], const Unit& u, int wr, int wc, int fr, int fq) const {
        const int row0 = u.pm * BM + wr * 64 + fr, col0 = u.pn * BM + wc * 32 + 8 * fq;
        EPI_LOOP_AI_M { unsigned char* rowp = O + (size_t)(row0 + ai * HALF + m * 16) * ldc + col0;
#pragma unroll
            for (int bj = 0; bj < 2; ++bj) { const f32x4 v0 = acc[ai][bj][m][0] * scale, v1 = acc[ai][bj][m][1] * scale;
                v2u w; w.x = pk4_fp8(v0[0], v0[1], v0[2], v0[3]); w.y = pk4_fp8(v1[0], v1[1], v1[2], v1[3]); *(v2u*)(rowp + bj * HALF) = w; } }
    }
};
struct EpiResIn {
    static constexpr bool PERM = true, AFTER_DRAIN = false, PERM16 = false;
    const float* X; bf16* XA; float* ssp; unsigned char* XA8;
    __device__ __forceinline__ void operator()(const f32x4 (&acc)[2][2][4][2], const Unit& u, int wr, int wc, int fr, int fq) const {
        const int row0 = u.pm * BM + wr * 64 + fr, col0 = u.pn * BM + wc * 32 + 8 * fq;
        EPI_LOOP_AI_M { const int r = row0 + ai * HALF + m * 16; const size_t off = (size_t)r * D + col0; float s = 0.f;
#pragma unroll
            for (int bj = 0; bj < 2; ++bj) { const f32x4 o0 = __builtin_nontemporal_load((const f32x4*)(X + off + bj * HALF)) + acc[ai][bj][m][0], o1 = __builtin_nontemporal_load((const f32x4*)(X + off + bj * HALF + 4)) + acc[ai][bj][m][1];
                s += ((o0[0] * o0[0] + o0[1] * o0[1]) + (o0[2] * o0[2] + o0[3] * o0[3])) + ((o1[0] * o1[0] + o1[1] * o1[1]) + (o1[2] * o1[2] + o1[3] * o1[3]));
                v4u w; w.x = cvt_pk_bf16(o0[0], o0[1]); w.y = cvt_pk_bf16(o0[2], o0[3]); w.z = cvt_pk_bf16(o1[0], o1[1]); w.w = cvt_pk_bf16(o1[2], o1[3]);
                *(v4u*)(XA + off + bj * HALF) = w;
                v2u w8; w8.x = pk4_fp8(o0[0] * XASCALE, o0[1] * XASCALE, o0[2] * XASCALE, o0[3] * XASCALE); w8.y = pk4_fp8(o1[0] * XASCALE, o1[1] * XASCALE, o1[2] * XASCALE, o1[3] * XASCALE);
                *(v2u*)(XA8 + off + bj * HALF) = w8; }
            s += __shfl_xor(s, 16); s += __shfl_xor(s, 32); if (fq == 0) ssp[(size_t)r * 16 + u.pn * 4 + wc] = s;
            if (m & 1) asm volatile("" ::: "memory"); }
    }
};
struct EpiResB {
    static constexpr bool PERM = true, AFTER_DRAIN = false, PERM16 = false;
    const bf16* Xb; bf16* O; float inv;
    __device__ __forceinline__ void operator()(const f32x4 (&acc)[2][2][4][2], const Unit& u, int wr, int wc, int fr, int fq) const {
        const int row0 = u.pm * BM + wr * 64 + fr, col0 = u.pn * BM + wc * 32 + 8 * fq;
        EPI_LOOP_AI_M { const size_t off = (size_t)(row0 + ai * HALF + m * 16) * D + col0;
#pragma unroll
            for (int bj = 0; bj < 2; ++bj) { const v4u xb = *(const v4u*)(Xb + off + bj * HALF);
                const f32x4 a0 = acc[ai][bj][m][0] * inv, a1 = acc[ai][bj][m][1] * inv;
                v4u w; w.x = cvt_pk_bf16(bf2f(xb.x & 0xffffu) + a0[0], bf2f(xb.x >> 16) + a0[1]); w.y = cvt_pk_bf16(bf2f(xb.y & 0xffffu) + a0[2], bf2f(xb.y >> 16) + a0[3]);
                w.z = cvt_pk_bf16(bf2f(xb.z & 0xffffu) + a1[0], bf2f(xb.z >> 16) + a1[1]); w.w = cvt_pk_bf16(bf2f(xb.w & 0xffffu) + a1[2], bf2f(xb.w >> 16) + a1[3]);
                *(v4u*)(O + off + bj * HALF) = w; }
            if (m & 1) asm volatile("" ::: "memory"); }
    }
};
struct EpiGU {
    static constexpr bool PERM = true, AFTER_DRAIN = false, PERM16 = true;
    unsigned char* O; const float* bias;
    __device__ __forceinline__ void operator()(const f32x4 (&acc)[2][2][4][2], const Unit& u, int wr, int wc, int fr, int fq) const {
        const int row0 = u.pm * BM + wr * 64 + fr, col0 = u.pn * BM + wc * 64 + 16 * fq;
        constexpr float inv = 1.f / (XSCALE * WSCALE);
        f32x4 bv[2][2];
#pragma unroll
        for (int bj = 0; bj < 2; ++bj)
#pragma unroll
            for (int n = 0; n < 2; ++n) bv[bj][n] = *(const f32x4*)(bias + (size_t)u.aux * NGU + col0 + 8 * bj + 4 * n);
        EPI_LOOP_AI_M { unsigned char* rowp = O + (size_t)(row0 + ai * HALF + m * 16) * D + (col0 >> 1);
            v2u w;
#pragma unroll
            for (int bj = 0; bj < 2; ++bj) { const f32x4 v0 = acc[ai][bj][m][0] * inv + bv[bj][0], v1 = acc[ai][bj][m][1] * inv + bv[bj][1];
                float o[4];
#pragma unroll
                for (int j = 0; j < 4; ++j) { float gg = (j < 2) ? v0[2 * j] : v1[2 * j - 4], uu = (j < 2) ? v0[2 * j + 1] : v1[2 * j - 3];
                    gg = fminf(gg, 7.f); uu = fminf(fmaxf(uu, -7.f), 7.f);
                    const float glu = gg * __builtin_amdgcn_rcpf(1.f + __builtin_amdgcn_exp2f(-1.702f * 1.4426950408889634f * gg)); o[j] = __builtin_fmaf(uu, ASCALE, ASCALE) * glu; }
                int t = __builtin_amdgcn_cvt_pk_fp8_f32(o[0], o[1], 0, false); t = __builtin_amdgcn_cvt_pk_fp8_f32(o[2], o[3], t, true); if (bj == 0) w.x = (unsigned)t; else w.y = (unsigned)t; }
            *(v2u*)rowp = w; }
    }
};
constexpr float Y8SCALE = 8.f, Y8MAX = 440.f;
struct EpiDown {
    static constexpr bool PERM = true, AFTER_DRAIN = false, PERM16 = true;
    unsigned char* O; const float* bias; const float* rgate;
    __device__ __forceinline__ void operator()(const f32x4 (&acc)[2][2][4][2], const Unit& u, int wr, int wc, int fr, int fq) const {
        const int row0 = u.pm * BM + wr * 64 + fr, col0 = u.pn * BM + wc * 64 + 16 * fq;
        f32x4 bv[2][2];
#pragma unroll
        for (int bj = 0; bj < 2; ++bj)
#pragma unroll
            for (int n = 0; n < 2; ++n) bv[bj][n] = *(const f32x4*)(bias + (size_t)u.aux * D + col0 + 8 * bj + 4 * n);
        constexpr float inv = 1.f / (ASCALE * WSCALE);
        EPI_LOOP_AI_M { const int r = row0 + ai * HALF + m * 16; const float gs = rgate[r] * Y8SCALE; unsigned char* rowp = O + (size_t)r * D + col0;
            v4u w;
#pragma unroll
            for (int bj = 0; bj < 2; ++bj) { f32x4 v0 = (acc[ai][bj][m][0] * inv + bv[bj][0]) * gs, v1 = (acc[ai][bj][m][1] * inv + bv[bj][1]) * gs;
#pragma unroll
                for (int j = 0; j < 4; ++j) { v0[j] = __builtin_amdgcn_fmed3f(v0[j], -Y8MAX, Y8MAX); v1[j] = __builtin_amdgcn_fmed3f(v1[j], -Y8MAX, Y8MAX); }
                int t = __builtin_amdgcn_cvt_pk_fp8_f32(v0[0], v0[1], 0, false); t = __builtin_amdgcn_cvt_pk_fp8_f32(v0[2], v0[3], t, true); const unsigned a = (unsigned)t;
                t = __builtin_amdgcn_cvt_pk_fp8_f32(v1[0], v1[1], 0, false); t = __builtin_amdgcn_cvt_pk_fp8_f32(v1[2], v1[3], t, true);
                if (bj == 0) { w.x = a; w.y = (unsigned)t; } else { w.z = a; w.w = (unsigned)t; } }
            *(v4u*)rowp = w; }
    }
};
struct EpiSoftmax {
    static constexpr bool PERM = true, AFTER_DRAIN = true, PERM16 = false;
    unsigned char* O; int ldc; const float* ssp;
    __device__ __forceinline__ void fused(f32x4 (&acc)[2][2][4][2], const Unit& u, int wr, int wc, int fr, int fq, LAS unsigned char* lds, int wid, int lane) const {
        LAS f32x2* T = (LAS f32x2*)lds;
        EPI_LOOP_AI_M { const int row = ai * HALF + wr * 64 + m * 16 + fr;
            const f32x4 p = *(const f32x4*)(ssp + (size_t)(u.pm * BM + row) * 16 + 4 * fq);
            float sq = (p[0] + p[1]) + (p[2] + p[3]); sq += __shfl_xor(sq, 16); sq += __shfl_xor(sq, 32);
            const float sc = (QXSCALE / (XASCALE * MVSCALE)) / sqrtf(sq * (1.f / D) + EPS);
            float mx = -INFINITY;
#pragma unroll
            for (int bj = 0; bj < 2; ++bj)
#pragma unroll
                for (int n = 0; n < 2; ++n) { const f32x4 x = acc[ai][bj][m][n] * sc; acc[ai][bj][m][n] = x; mx = fmaxf(mx, fmaxf(fmaxf(x[0], x[1]), fmaxf(x[2], x[3]))); }
            mx = fmaxf(mx, __shfl_xor(mx, 16)); mx = fmaxf(mx, __shfl_xor(mx, 32));
            float s = 0.f;
#pragma unroll
            for (int bj = 0; bj < 2; ++bj)
#pragma unroll
                for (int n = 0; n < 2; ++n) { f32x4 x = acc[ai][bj][m][n];
#pragma unroll
                    for (int j = 0; j < 4; ++j) { x[j] = __builtin_amdgcn_exp2f(x[j] - mx); s += x[j]; }
                    acc[ai][bj][m][n] = x; }
            s += __shfl_xor(s, 16); s += __shfl_xor(s, 32);
            if (fq == 0) T[row * 4 + wc] = (f32x2){mx, s};
            __builtin_amdgcn_sched_barrier(0); }
        asm volatile("s_waitcnt lgkmcnt(0)" ::: "memory"); __builtin_amdgcn_s_barrier(); asm volatile("" ::: "memory");
        EPI_LOOP_AI_M { const int row = ai * HALF + wr * 64 + m * 16 + fr;
            const f32x2 t0 = T[row * 4 + 0], t1 = T[row * 4 + 1], t2 = T[row * 4 + 2], t3 = T[row * 4 + 3];
            const float M = fmaxf(fmaxf(t0.x, t1.x), fmaxf(t2.x, t3.x));
            const float S = (t0.y * __builtin_amdgcn_exp2f(t0.x - M) + t1.y * __builtin_amdgcn_exp2f(t1.x - M)) + (t2.y * __builtin_amdgcn_exp2f(t2.x - M) + t3.y * __builtin_amdgcn_exp2f(t3.x - M));
            const float f = __builtin_amdgcn_exp2f(T[row * 4 + wc].x - M) * PSCALE / S;
            unsigned char* rowp = O + (size_t)(u.pm * BM + row) * ldc + u.pn * BM + wc * 32 + 8 * fq;
#pragma unroll
            for (int bj = 0; bj < 2; ++bj) { const f32x4 v0 = acc[ai][bj][m][0] * f, v1 = acc[ai][bj][m][1] * f;
                v2u w; w.x = pk4_fp8(v0[0], v0[1], v0[2], v0[3]); w.y = pk4_fp8(v1[0], v1[1], v1[2], v1[3]);
                *(v2u*)(rowp + bj * HALF) = w; }
            __builtin_amdgcn_sched_barrier(0); }
        asm volatile("s_waitcnt lgkmcnt(0)" ::: "memory"); __builtin_amdgcn_s_barrier(); asm volatile("" ::: "memory");
    }
};
}

constexpr int CONV_RUN = 4;
__device__ __forceinline__ void conv_run(Frame& F, int tok0) {
    const int lane = F.lane, t0 = tok0 % SEQ, c0 = 8 * lane;
    const bf16* p0 = F.PROJ() + (size_t)tok0 * NPROJ + c0;
    float w[3][8], gq[8];
#pragma unroll
    for (int i = 0; i < 3; ++i) { const f32x4 w0 = *(const f32x4*)(F.w_conv() + i * CW + c0), w1 = *(const f32x4*)(F.w_conv() + i * CW + c0 + 4);
#pragma unroll
        for (int j = 0; j < 4; ++j) { w[i][j] = w0[j]; w[i][4 + j] = w1[j]; } }
    { const f32x4 g0 = *(const f32x4*)(F.g_conv() + c0), g1 = *(const f32x4*)(F.g_conv() + c0 + 4);
#pragma unroll
      for (int j = 0; j < 4; ++j) { gq[j] = g0[j]; gq[4 + j] = g1[j]; } }
    float vm2[8], vm1[8];
#pragma unroll
    for (int j = 0; j < 8; ++j) { vm2[j] = 0.f; vm1[j] = 0.f; }
    if (t0 >= 2) { float u[8], gc[8]; unpack8(*(const v4u*)(p0 - 2 * NPROJ), u); unpack8(*(const v4u*)(p0 - 2 * NPROJ + 2 * CW), gc);
#pragma unroll
        for (int j = 0; j < 8; ++j) vm2[j] = gc[j] * u[j]; }
    if (t0 >= 1) { float u[8], gc[8]; unpack8(*(const v4u*)(p0 - NPROJ), u); unpack8(*(const v4u*)(p0 - NPROJ + 2 * CW), gc);
#pragma unroll
        for (int j = 0; j < 8; ++j) vm1[j] = gc[j] * u[j]; }
#pragma unroll
    for (int bt = 0; bt < CONV_RUN; bt += 4) {
        v4u ru[4], rb[4], rc[4];
#pragma unroll
        for (int i = 0; i < 4; ++i) { const bf16* p = p0 + (size_t)(bt + i) * NPROJ; ru[i] = *(const v4u*)p; rb[i] = *(const v4u*)(p + CW); rc[i] = *(const v4u*)(p + 2 * CW); }
#pragma unroll
        for (int i = 0; i < 4; ++i) { float u[8], gb[8], gc[8], y[8]; unpack8(ru[i], u); unpack8(rb[i], gb); unpack8(rc[i], gc);
            float s = 0.f;
#pragma unroll
            for (int j = 0; j < 8; ++j) { const float v0 = gc[j] * u[j]; y[j] = gb[j] * (w[0][j] * vm2[j] + w[1][j] * vm1[j] + w[2][j] * v0); vm2[j] = vm1[j]; vm1[j] = v0; s += y[j] * y[j]; }
            const float rstd = 1.f / sqrtf(wave_sum(s) * (1.f / CW) + EPS);
            v4u o; o.x = pk2(y[0] * rstd * gq[0], y[1] * rstd * gq[1]); o.y = pk2(y[2] * rstd * gq[2], y[3] * rstd * gq[3]);
            o.z = pk2(y[4] * rstd * gq[4], y[5] * rstd * gq[5]); o.w = pk2(y[6] * rstd * gq[6], y[7] * rstd * gq[7]);
            *(v4u*)(F.YMIX() + (size_t)(tok0 + bt + i) * D + c0) = o; }
    }
}

namespace sba {
typedef short bf16x8 __attribute__((ext_vector_type(8)));
typedef short s16x4 __attribute__((ext_vector_type(4)));
typedef float f32x16 __attribute__((ext_vector_type(16)));
typedef short v4i16_t __attribute__((ext_vector_type(4)));
constexpr float EXIT2 = -104.f * 1.4426950408889634f;
constexpr int WLDS = 16384, OST = 4096, OPITCH = 65;
__device__ __forceinline__ s16x4 vtr(const LAS unsigned char* p) { return __builtin_bit_cast(s16x4, __builtin_amdgcn_ds_read_tr16_b64_v4i16((LAS v4i16_t*)p)); }
typedef float f32x2_t __attribute__((ext_vector_type(2))); typedef __bf16 bf16x2_t __attribute__((ext_vector_type(2)));
__device__ __forceinline__ unsigned cvtpk(float lo, float hi) { f32x2_t v = {lo, hi}; bf16x2_t b = __builtin_convertvector(v, bf16x2_t); return __builtin_bit_cast(unsigned, b); }
__device__ __forceinline__ int krow(int r, int hh) { return (r & 3) + 8 * (r >> 2) + 4 * hh; }
struct TagT { static constexpr bool value = true; }; struct TagF { static constexpr bool value = false; };

__device__ __forceinline__ void sb_first(Frame& F, int u, bf16x8 (&qf)[4], bf16x8 (&kf)[4], v4u (&vr)[4]) {
    const int qt = u % (SEQ / 32), bh = u / (SEQ / 32), b = bh / SBH, h = bh % SBH, lane = F.lane, r32 = lane & 31, hh = lane >> 5;
    const bf16* base = F.PROJ() + (size_t)b * SEQ * NPROJ + h * SBD; const size_t ko = (size_t)(qt * 32) * NPROJ;
    const bf16* qp = base + ko + (size_t)r32 * NPROJ + PQ + 8 * hh; const bf16* kp = base + (size_t)r32 * NPROJ + PK + 8 * hh; const bf16* vp = base + (size_t)(lane >> 3) * NPROJ + PV + 8 * (lane & 7);
#pragma unroll
    for (int s = 0; s < 4; ++s) qf[s] = *(const bf16x8*)(qp + 16 * s);
#pragma unroll
    for (int s = 0; s < 4; ++s) kf[s] = *(const bf16x8*)(kp + ko + 16 * s);
#pragma unroll
    for (int i = 0; i < 4; ++i) vr[i] = *(const v4u*)(vp + ko + (size_t)(8 * i) * NPROJ);
}
__device__ __forceinline__ void sb_unit(Frame& F, int b, int h, int qt, LAS unsigned char* wl, const bf16x8 (&Uf)[2], bf16x8 (&qf)[4], bf16x8 (&kf)[4], v4u (&vr)[4], int unext) {
    const int lane = F.lane, r32 = lane & 31, hh = lane >> 5;
    const bf16* base = F.PROJ() + (size_t)b * SEQ * NPROJ + h * SBD;
    const bf16* kp = base + (size_t)r32 * NPROJ + PK + 8 * hh;
    const bf16* vp = base + (size_t)(lane >> 3) * NPROJ + PV + 8 * (lane & 7);
    const int c = lane & 7;
    const int vw0 = (c >> 2) * 2048 + (c & 3) * 16 + (lane >> 3) * 64;
    const int vb = ((lane >> 4) & 1) * 32 + (lane & 3) * 8 + (4 * hh + ((lane & 15) >> 2)) * 64;
    f32x16 o0, o1;
#pragma unroll
    for (int r = 0; r < 16; ++r) { o0[r] = 0.f; o1[r] = 0.f; }
    float carry = 0.f;
    auto step = [&](auto diag_tag, const int kt) -> bool {
        constexpr bool DIAG = decltype(diag_tag)::value;
        asm volatile("" ::: "memory");
#pragma unroll
        for (int i = 0; i < 4; ++i) *(LAS v4u*)(wl + vw0 + (i & 1) * 512 + (i >> 1) * 1024) = vr[i];
        asm volatile("" ::: "memory");
        bf16x8 kc[4];
#pragma unroll
        for (int s = 0; s < 4; ++s) kc[s] = kf[s];
        if (kt > 0) { const size_t ko = (size_t)((kt - 1) * 32) * NPROJ;
#pragma unroll
            for (int s = 0; s < 4; ++s) kf[s] = *(const bf16x8*)(kp + ko + 16 * s);
#pragma unroll
            for (int i = 0; i < 4; ++i) vr[i] = *(const v4u*)(vp + ko + (size_t)(8 * i) * NPROJ); }
        f32x16 z;
#pragma unroll
        for (int r = 0; r < 16; ++r) z[r] = 0.f;
#pragma unroll
        for (int s = 0; s < 4; ++s) z = __builtin_amdgcn_mfma_f32_32x32x16_bf16(kc[s], qf[s], z, 0, 0, 0);
        f32x16 L; float csum = 0.f;
#pragma unroll
        for (int r = 0; r < 16; ++r) { const float zz = z[r];
            const float e = __builtin_amdgcn_exp2f(-fabsf(zz)); const float lg = __builtin_amdgcn_logf(1.f + e);
            const float sp = __builtin_amdgcn_fmed3f(zz, 0.f, 3.0e38f) + lg;
            if constexpr (DIAG) { const bool valid = krow(r, hh) < r32; L[r] = valid ? -sp : 0.f; } else L[r] = -sp;
            csum += L[r]; }
        bf16x8 Lb[2];
#pragma unroll
        for (int s = 0; s < 2; ++s) { v4u w; w.x = cvtpk(L[8 * s + 0], L[8 * s + 1]); w.y = cvtpk(L[8 * s + 2], L[8 * s + 3]); w.z = cvtpk(L[8 * s + 4], L[8 * s + 5]); w.w = cvtpk(L[8 * s + 6], L[8 * s + 7]); Lb[s] = __builtin_bit_cast(bf16x8, w); }
        f32x16 Y;
#pragma unroll
        for (int r = 0; r < 16; ++r) Y[r] = carry;
        Y = __builtin_amdgcn_mfma_f32_32x32x16_bf16(Uf[0], Lb[0], Y, 0, 0, 0);
        Y = __builtin_amdgcn_mfma_f32_32x32x16_bf16(Uf[1], Lb[1], Y, 0, 0, 0);
#pragma unroll
        for (int r = 0; r < 16; ++r) { const float a = __builtin_amdgcn_exp2f(z[r] + L[r] + Y[r]);
            if constexpr (DIAG) { const bool valid = krow(r, hh) < r32; z[r] = valid ? a : 0.f; } else z[r] = a; }
        bf16x8 Pa[2];
#pragma unroll
        for (int s = 0; s < 2; ++s) { v4u w; w.x = cvtpk(z[8 * s + 0], z[8 * s + 1]); w.y = cvtpk(z[8 * s + 2], z[8 * s + 3]); w.z = cvtpk(z[8 * s + 4], z[8 * s + 5]); w.w = cvtpk(z[8 * s + 6], z[8 * s + 7]); Pa[s] = __builtin_bit_cast(bf16x8, w); }
        { auto rr = __builtin_amdgcn_permlane32_swap(__float_as_uint(csum), __float_as_uint(csum), false, false); carry += __uint_as_float(rr[0]) + __uint_as_float(rr[1]); }
#pragma unroll
        for (int d0 = 0; d0 < 2; ++d0)
#pragma unroll
            for (int ks = 0; ks < 2; ++ks) { const s16x4 lo = vtr(wl + vb + d0 * 2048 + ks * 1024), hi = vtr(wl + vb + d0 * 2048 + ks * 1024 + 512);
                const bf16x8 vf = (bf16x8){lo[0], lo[1], lo[2], lo[3], hi[0], hi[1], hi[2], hi[3]};
                if (d0 == 0) o0 = __builtin_amdgcn_mfma_f32_32x32x16_bf16(Pa[ks], vf, o0, 0, 0, 0); else o1 = __builtin_amdgcn_mfma_f32_32x32x16_bf16(Pa[ks], vf, o1, 0, 0, 0); }
        return __all(carry < EXIT2) != 0;
    };
    if (!step(TagT{}, qt)) for (int kt = qt - 1; kt >= 0; --kt) if (step(TagF{}, kt)) break;
    if (unext >= 0) sb_first(F, unext, qf, kf, vr);
    asm volatile("" ::: "memory");
    LAS float* ost = (LAS float*)(wl + OST);
#pragma unroll
    for (int r = 0; r < 16; ++r) { const int q = krow(r, hh); ost[q * OPITCH + r32] = o0[r]; ost[q * OPITCH + 32 + r32] = o1[r]; }
    asm volatile("" ::: "memory");
    const int q = lane >> 1, half = lane & 1;
    float v[32]; float ss = 0.f;
#pragma unroll
    for (int i = 0; i < 32; ++i) { v[i] = ost[q * OPITCH + half * 32 + i]; ss += v[i] * v[i]; }
    ss += __shfl_xor(ss, 1);
    const float rstd = 1.f / sqrtf(ss * (1.f / SBD) + EPS);
    const float* g = F.g_sb() + h * SBD + half * 32;
    bf16* orow = F.YMIX() + (size_t)(b * SEQ + qt * 32 + q) * D + CW + h * SBD + half * 32;
#pragma unroll
    for (int i = 0; i < 4; ++i) { const f32x4 g0 = *(const f32x4*)(g + 8 * i), g1 = *(const f32x4*)(g + 8 * i + 4);
        v4u w; w.x = cvtpk(v[8 * i + 0] * rstd * g0[0], v[8 * i + 1] * rstd * g0[1]); w.y = cvtpk(v[8 * i + 2] * rstd * g0[2], v[8 * i + 3] * rstd * g0[3]);
        w.z = cvtpk(v[8 * i + 4] * rstd * g1[0], v[8 * i + 5] * rstd * g1[1]); w.w = cvtpk(v[8 * i + 6] * rstd * g1[2], v[8 * i + 7] * rstd * g1[3]);
        *(v4u*)(orow + 8 * i) = w; }
    asm volatile("" ::: "memory");
}
__device__ __forceinline__ void sb_phase(Frame& F, int gw, int NGW) {
    const int lane = F.lane, r32 = lane & 31, hh = lane >> 5;
    bf16x8 Uf[2];
#pragma unroll
    for (int s = 0; s < 2; ++s)
#pragma unroll
        for (int j = 0; j < 8; ++j) { const int k = 16 * s + 8 * (j >> 2) + 4 * hh + (j & 3); Uf[s][j] = (k > r32) ? (short)0x3F80 : (short)0; }
    LAS unsigned char* wl = F.lds + F.wave * WLDS;
    constexpr int NU = BATCH * SBH * (SEQ / 32); bf16x8 qf[4], kf[4]; v4u vr[4];
    if (gw < NU) sb_first(F, gw, qf, kf, vr);
    for (int u = gw; u < NU; u += NGW) { const int qt = u % (SEQ / 32), bh = u / (SEQ / 32); sb_unit(F, bh / SBH, bh % SBH, qt, wl, Uf, qf, kf, vr, u + NGW < NU ? u + NGW : -1); }
}
}

constexpr int RT_OFF = 132096;
constexpr int CW_ECNT = 8192;
__device__ __forceinline__ void router_phase(Frame& F) {
    typedef short bf16x8 __attribute__((ext_vector_type(8))); typedef float f32x16 __attribute__((ext_vector_type(16)));
    constexpr int RP = 33;
    LAS float* red = (LAS float*)F.lds;
    LAS float* ssq = red + 4 * 64 * RP;
    LAS float* rstdL = ssq + 256;
    LAS int* hist = (LAS int*)(F.lds + RT_OFF); LAS int* base = hist + 32; LAS int* aexp = base + 32; LAS int* arank = aexp + 256; LAS float* agate = (LAS float*)(arank + 256);
    const int lane = F.lane, r32 = lane & 31, hh = lane >> 5, grp = F.wave & 1, q = F.wave >> 1;
    int* ecnt = (int*)(F.a.ws + WS_CTL) + CW_ECNT;
    const bf16* wp0 = F.WrT() + ((size_t)(q * 16) * 2 * 64 + lane) * 8;
    for (int tb = F.vcu; tb < NTOK / 64; tb += F.G) {
        if (F.tid < NE) hist[F.tid] = 0;
        const int tl = grp * 32 + r32, token = tb * 64 + tl;
#pragma unroll
        for (int i = 0; i < 16; ++i) { const int hr = F.wave * 16 + i, t = hr >> 1, half = hr & 1;
            unsigned vo = (unsigned)(lane ^ (t & 15)) * 16u; asm volatile("" : "+v"(vo));
            __builtin_amdgcn_global_load_lds((const unsigned*)((const char*)(F.X2B() + (size_t)(tb * 64 + t) * D + half * 512) + vo), (LAS unsigned*)(F.lds + hr * 1024), 16, 0, 0); }
        asm volatile("s_waitcnt vmcnt(0)" ::: "memory"); __syncthreads();
        f32x16 ch;
#pragma unroll
        for (int r = 0; r < 16; ++r) ch[r] = 0.f;
        float sq = 0.f;
        const LAS unsigned char* xl = F.lds + tl * 2048 + (q >> 1) * 1024;
#pragma unroll
        for (int hf = 0; hf < 2; ++hf) {
            bf16x8 bhi[8], blo[8];
#pragma unroll
            for (int s = 0; s < 8; ++s) { const int st = 8 * hf + s; bhi[s] = *(const bf16x8*)(wp0 + (size_t)(2 * st) * 512); blo[s] = *(const bf16x8*)(wp0 + (size_t)(2 * st + 1) * 512); }
#pragma unroll
            for (int s = 0; s < 8; ++s) { const int st = 8 * hf + s, c = (q & 1) * 32 + 2 * st + hh;
                const bf16x8 a = *(const LAS bf16x8*)(xl + ((c ^ (tl & 15)) * 16));
                ch = __builtin_amdgcn_mfma_f32_32x32x16_bf16(a, bhi[s], ch, 0, 0, 0); ch = __builtin_amdgcn_mfma_f32_32x32x16_bf16(a, blo[s], ch, 0, 0, 0);
                float f[8]; unpack8(__builtin_bit_cast(v4u, a), f);
#pragma unroll
                for (int j = 0; j < 8; ++j) sq += f[j] * f[j]; }
            __builtin_amdgcn_sched_barrier(0);
        }
        __syncthreads();
        { auto rr = __builtin_amdgcn_permlane32_swap(__float_as_uint(sq), __float_as_uint(sq), false, false); sq = __uint_as_float(rr[0]) + __uint_as_float(rr[1]); }
        if (hh == 0) ssq[q * 64 + tl] = sq;
#pragma unroll
        for (int r = 0; r < 16; ++r) { const int t = grp * 32 + (r & 3) + 8 * (r >> 2) + 4 * hh; red[(q * 64 + t) * RP + r32] = ch[r]; }
        __syncthreads();
        if (F.wave == 0) {
            const int t = lane;
            const float rstd = 1.f / sqrtf(((ssq[t] + ssq[64 + t]) + (ssq[128 + t] + ssq[192 + t])) * (1.f / D) + EPS);
            rstdL[t] = rstd;
            float lg[32];
#pragma unroll
            for (int e = 0; e < 32; ++e) { float v = 0.f;
#pragma unroll
                for (int qq = 0; qq < 4; ++qq) v += red[(qq * 64 + t) * RP + e];
                lg[e] = v * rstd + F.b_router()[e]; }
            float tv[4]; int ti[4];
#pragma unroll
            for (int r = 0; r < 4; ++r) { float m = -INFINITY; int mi = 0;
#pragma unroll
                for (int e = 0; e < 32; ++e) { const bool gt = lg[e] > m; m = gt ? lg[e] : m; mi = gt ? e : mi; }
                tv[r] = m; ti[r] = mi;
#pragma unroll
                for (int e = 0; e < 32; ++e) lg[e] = (e == mi) ? -INFINITY : lg[e]; }
            const float e1 = __expf(tv[1] - tv[0]), e2 = __expf(tv[2] - tv[0]), e3 = __expf(tv[3] - tv[0]); const float inv = 1.f / (1.f + e1 + e2 + e3);
            const float gt[4] = {inv, e1 * inv, e2 * inv, e3 * inv};
#pragma unroll
            for (int r = 0; r < 4; ++r) { const int a = t * 4 + r; aexp[a] = ti[r]; agate[a] = gt[r]; arank[a] = atomicAdd((int*)&hist[ti[r]], 1); }
        }
        __syncthreads();
        {
#pragma unroll
          for (int i = 0; i < 8; ++i) { const int t = F.wave * 8 + i; const float rs = rstdL[t] * XSCALE;
              const v4u* ip = (const v4u*)(F.X2B() + (size_t)(tb * 64 + t) * D + 16 * lane); float f[8], g[8]; unpack8(ip[0], f); unpack8(ip[1], g);
              v4u w; w.x = pk4_fp8(f[0] * rs, f[1] * rs, f[2] * rs, f[3] * rs); w.y = pk4_fp8(f[4] * rs, f[5] * rs, f[6] * rs, f[7] * rs);
              w.z = pk4_fp8(g[0] * rs, g[1] * rs, g[2] * rs, g[3] * rs); w.w = pk4_fp8(g[4] * rs, g[5] * rs, g[6] * rs, g[7] * rs);
              *(v4u*)(F.XB8() + (size_t)(tb * 64 + t) * D + 16 * lane) = w; } }
        if (F.tid < NE) { const int h = hist[F.tid]; base[F.tid] = h ? atomicAdd(ecnt + F.tid, h) : 0; }
        __syncthreads();
        if (F.tid < 256) { const int a = F.tid, e = aexp[a], rank = base[e] + arank[a], tk = tb * 64 + (a >> 2);
            F.LTOK()[e * NTOK + rank] = tk; F.LGATE()[e * NTOK + rank] = agate[a]; F.SLOT()[tk * 4 + (a & 3)] = rank; F.TOPI()[tk * 4 + (a & 3)] = e; }
        __syncthreads();
    }
}

struct MoeTab { LAS int* cnt; LAS int* pst; LAS int* texp; LAS int* gl; };
__device__ __forceinline__ MoeTab moe_tab(Frame& F) { MoeTab T; T.cnt = (LAS int*)(F.lds + RT_OFF); T.pst = T.cnt + 32; T.texp = T.pst + 40; T.gl = (LAS int*)(F.lds + RT_OFF + 2048); return T; }
__device__ __forceinline__ int moe_setup(Frame& F, const MoeTab& T) {
    const int* ecnt = (const int*)(F.a.ws + WS_CTL) + CW_ECNT;
    __syncthreads();
    if (F.tid < NE) T.cnt[F.tid] = __hip_atomic_load(ecnt + F.tid, __ATOMIC_RELAXED, __HIP_MEMORY_SCOPE_AGENT);
    __syncthreads();
    if (F.tid < NE) {
        const int e = F.tid, ntl = (T.cnt[e] + 255) >> 8; int inc = ntl;
#pragma unroll
        for (int d = 1; d < NE; d <<= 1) { const int o = __shfl_up(inc, d, 64); if (e >= d) inc += o; }
        const int t0 = inc - ntl; T.pst[e] = t0 << 8; if (e == NE - 1) T.pst[NE] = inc << 8;
        for (int j = 0; j < ntl; ++j) T.texp[t0 + j] = e; }
    __syncthreads();
    return T.pst[NE] >> 8;
}

__device__ __forceinline__ void final_phase(Frame& F, float* dst, const LAS int* pst) {
    const int gw = F.vcu * NWAVES + F.wave, NGW = F.G * NWAVES, lane = F.lane;
    f32x4 gf[4];
#pragma unroll
    for (int j = 0; j < 2; ++j) { gf[2 * j] = *(const f32x4*)(F.g_final() + 8 * lane + 512 * j); gf[2 * j + 1] = *(const f32x4*)(F.g_final() + 8 * lane + 512 * j + 4); }
    for (int t0 = gw * 2; t0 < NTOK; t0 += NGW * 2) {
        int sl[2][4]; f32x4 v[2][4]; v2u y[2][4][2];
#pragma unroll
        for (int tt = 0; tt < 2; ++tt)
#pragma unroll
            for (int k = 0; k < 4; ++k) sl[tt][k] = pst[F.TOPI()[(t0 + tt) * 4 + k]] + F.SLOT()[(t0 + tt) * 4 + k];
#pragma unroll
        for (int tt = 0; tt < 2; ++tt)
#pragma unroll
            for (int j = 0; j < 2; ++j) { float f[8]; unpack8(*(const v4u*)(F.X2B() + (size_t)(t0 + tt) * D + 8 * lane + 512 * j), f); v[tt][2 * j] = (f32x4){f[0], f[1], f[2], f[3]}; v[tt][2 * j + 1] = (f32x4){f[4], f[5], f[6], f[7]}; }
#pragma unroll
        for (int tt = 0; tt < 2; ++tt)
#pragma unroll
            for (int k = 0; k < 4; ++k)
#pragma unroll
                for (int j = 0; j < 2; ++j) y[tt][k][j] = __builtin_nontemporal_load((const v2u*)((const unsigned char*)F.Y() + (size_t)sl[tt][k] * D + 8 * lane + 512 * j));
#pragma unroll
        for (int tt = 0; tt < 2; ++tt) {
#pragma unroll
            for (int k = 0; k < 4; ++k)
#pragma unroll
                for (int j = 0; j < 2; ++j) { const pg8::f32x2 f0 = __builtin_amdgcn_cvt_pk_f32_fp8((int)y[tt][k][j].x, false), f1 = __builtin_amdgcn_cvt_pk_f32_fp8((int)y[tt][k][j].x, true),
                                                  f2 = __builtin_amdgcn_cvt_pk_f32_fp8((int)y[tt][k][j].y, false), f3 = __builtin_amdgcn_cvt_pk_f32_fp8((int)y[tt][k][j].y, true);
                    constexpr float is = 1.f / pg8::Y8SCALE;
                    v[tt][2 * j][0] += f0.x * is; v[tt][2 * j][1] += f0.y * is; v[tt][2 * j][2] += f1.x * is; v[tt][2 * j][3] += f1.y * is;
                    v[tt][2 * j + 1][0] += f2.x * is; v[tt][2 * j + 1][1] += f2.y * is; v[tt][2 * j + 1][2] += f3.x * is; v[tt][2 * j + 1][3] += f3.y * is; }
            float s = 0.f;
#pragma unroll
            for (int j = 0; j < 4; ++j) s += (v[tt][j].x * v[tt][j].x + v[tt][j].y * v[tt][j].y) + (v[tt][j].z * v[tt][j].z + v[tt][j].w * v[tt][j].w);
            const float rstd = 1.f / sqrtf(wave_sum(s) * (1.f / D) + EPS);
#pragma unroll
            for (int j = 0; j < 2; ++j) { float* xp = dst + (size_t)(t0 + tt) * D + 8 * lane + 512 * j; *(f32x4*)xp = v[tt][2 * j] * rstd * gf[2 * j]; *(f32x4*)(xp + 4) = v[tt][2 * j + 1] * rstd * gf[2 * j + 1]; }
        }
    }
}

constexpr int NPHASE = 13;
#ifndef NSTREAM
#define NSTREAM 96
#endif
#ifndef MOE_WGM
#define MOE_WGM 4
#endif
#ifndef PROBE_DUP
#define PROBE_DUP -1
#endif
__global__ void __launch_bounds__(NWAVES * 64, 2) fwd_kernel(Args args) {
    extern __shared__ __attribute__((aligned(16))) unsigned char lds[];
    Frame F(args);
    F.lds = (LAS unsigned char*)lds;
    F.tid = threadIdx.x; F.lane = F.tid & 63; F.wave = __builtin_amdgcn_readfirstlane(F.tid >> 6);
    F.G = gridDim.x; { const int bx = blockIdx.x; F.vcu = (F.G % 8 == 0) ? (bx % 8) * (F.G / 8) + bx / 8 : bx; }
    unsigned char* ws = args.ws;
    for (int u = F.tid; u < (LDS_BYTES - LDSCTL_OFF) / 4; u += NWAVES * 64) ((LAS unsigned*)(F.lds + LDSCTL_OFF))[u] = 0u;
    __syncthreads();
    volatile LAS unsigned* MISC = (volatile LAS unsigned*)(F.lds + MISC_OFF);
    const bool one = (args.ph_hi - args.ph_lo) > 1;
    XcdBarrier bar; bar.bar = (unsigned*)(ws + WS_CTL) + CW_BAR; bar.x = 0; bar.st = nullptr;
    if (one) bar = xcd_barrier_post((unsigned*)(ws + WS_CTL) + CW_BAR, MISC + 8);
    const int lo = args.ph_lo, hi = args.ph_hi;
#define IN(k) (lo <= (k) && (k) < hi)
#define NEXTPH(k) ((k) == 8 ? 10 : (k) == 5 ? 7 : (k) == 3 ? 5 : (k) + 1)
#define SEAM(k) do { if (IN(k) && IN(NEXTPH(k))) { xcd_barrier(bar); if (PROBE_DUP == 99) xcd_barrier(bar); } } while (0)
    const int gw = F.vcu * NWAVES + F.wave, NGW = F.G * NWAVES;

    if (IN(0)) { p0_prologue(F); if (PROBE_DUP == 0) p0_prologue(F); SEAM(0); }
    if (IN(1)) {
        static_assert(NSTREAM == 96 && I_P1 == NSTREAM * NWAVES * 14 && (NTOK / 256) * (NPROJ / 256) == 4 * (256 - NSTREAM) + 128, "work split of the two roles");
        if ((int)blockIdx.x < NSTREAM && F.G == 256) {
            LAS unsigned* scr = (LAS unsigned*)(F.lds + F.wave * 16384);
            tr_run<true, false, true>(F, (int)blockIdx.x * NWAVES + F.wave, NSTREAM * NWAVES, I_P1, scr);
        } else if (F.G == 256) { const int c = (int)blockIdx.x - NSTREAM;
            { pg8::Gemm g{F.XN(), F.WinT(), D, D, D}; pg8::StaticOrder S; S.init(NTOK / 256, NPROJ / 256, F.G - NSTREAM, c, D, D, nullptr);
              pg8::EpiBf16 E{F.PROJ(), NPROJ, PQ / 256, PK / 256, SBQSCALE}; pg8::gemm_phase<pg8::EpiBf16, pg8::StaticOrder, true>(F.lds, g, S, E); if (PROBE_DUP == 1) { __syncthreads(); pg8::gemm_phase<pg8::EpiBf16, pg8::StaticOrder, true>(F.lds, g, S, E); } }
            if (c >= 128) { VM_WAIT(); __syncthreads();
                pg8::Gemm g{F.MN(), F.WxkvT(), D, D, D}; pg8::StaticOrder S; S.init(NMEM / 256, 2 * D / 256, 32, c - 128, D, D, nullptr);
                pg8::EpiKV E{F.KVX()}; pg8::gemm_phase<pg8::EpiKV, pg8::StaticOrder, true>(F.lds, g, S, E); } }
        SEAM(1); }
    if (IN(2)) {
        const int nkv = 32;
        if ((int)blockIdx.x < nkv) {
#pragma unroll 1
            for (int j4 = 0; j4 < 4; ++j4) { const int id = (int)blockIdx.x * 4 + j4, idx = id & 63, bh = idx >> 2, b = bh >> 2, h = bh & 3, part = idx & 3;
                const bool mt = id < 64;
                pg8::Gemm g{mt ? F.KVX() : F.WxoT(), mt ? F.WxqB() : F.KVX(), mt ? 2 * D : D, mt ? D : 2 * D, XAD};
                pg8::OneUnit S; S.u0.aux = 0; S.u0.pm = mt ? 0 : part; S.u0.pn = mt ? part : h;
                S.u0.a_off = mt ? (long)b * MEML * 2 * D + h * XAD : (long)part * 256 * D + h * XAD;
                S.u0.b_off = mt ? (long)part * 256 * D + h * XAD : (long)b * MEML * 2 * D + D + h * XAD;
                pg8::EpiF8 E{mt ? F.Mt8() + (size_t)b * D * D + (size_t)(h * 256) * D : F.Vt8() + (size_t)b * D * D, D, MVSCALE};
                pg8::gemm_phase<pg8::EpiF8, pg8::OneUnit, true>(F.lds, g, S, E);
                VM_WAIT(); __syncthreads(); }
        }
        if ((int)blockIdx.x >= nkv) {
            const int bx = (int)blockIdx.x - nkv, Gs = F.G - nkv; const int vc = (Gs % 8 == 0) ? (bx % 8) * (Gs / 8) + bx / 8 : bx;
            const int gws = vc * NWAVES + F.wave, NGWs = Gs * NWAVES;
            sba::sb_phase(F, gws, NGWs); if (PROBE_DUP == 2) sba::sb_phase(F, gws, NGWs);
            { constexpr int NRUN = NTOK / CONV_RUN; const int nheavy = (BATCH * SBH * (SEQ / 32)) % NGWs;
              if (gws < nheavy) { if (gws < NRUN) conv_run(F, gws * CONV_RUN); }
              else for (int tr = nheavy + (gws - nheavy); tr < NRUN; tr += NGWs - nheavy) conv_run(F, tr * CONV_RUN); }
        }
        SEAM(2);
    }
    if (IN(3)) {
        { pg8::Gemm g{F.YMIX(), F.WoutT(), D, D, D}; pg8::StaticOrder S; S.init(NTOK / 256, D / 256, F.G, (int)blockIdx.x, D, D, nullptr);
            pg8::EpiResIn E{F.x(), F.XA(), F.SSP1(), F.XA8()}; pg8::gemm_phase<pg8::EpiResIn, pg8::StaticOrder, true>(F.lds, g, S, E); if (PROBE_DUP == 3) { __syncthreads(); pg8::gemm_phase<pg8::EpiResIn, pg8::StaticOrder, true>(F.lds, g, S, E); } }
        SEAM(3); }
    if (IN(5)) {
        { const int un = F.vcu, rt = un >> 2, h = un & 3, b = rt / (SEQ / 256);
            pg8::Gemm g{(const bf16*)F.XA8(), (const bf16*)F.Mt8(), D / 2, D / 2, D / 2}; pg8::OneUnit S; S.u0.pm = rt; S.u0.pn = h; S.u0.aux = 0;
            S.u0.a_off = (long)rt * 256 * (D / 2); S.u0.b_off = (long)b * D * (D / 2) + (long)(h * 256) * (D / 2);
            pg8::EpiSoftmax E{F.PX8(), D, F.SSP1()}; pg8::gemm_phase<pg8::EpiSoftmax, pg8::OneUnit, false, true>(F.lds, g, S, E);
            if (PROBE_DUP == 5) { __syncthreads(); pg8::gemm_phase<pg8::EpiSoftmax, pg8::OneUnit, false, true>(F.lds, g, S, E); } }
        SEAM(5); }
    if (IN(7)) {
        { const int un = F.vcu, rt = un >> 2, pn = un & 3, b = rt / (SEQ / 256);
            pg8::Gemm g{(const bf16*)F.PX8(), (const bf16*)F.Vt8(), D / 2, D / 2, D / 2}; pg8::OneUnit S; S.u0.pm = rt; S.u0.pn = pn; S.u0.aux = 0;
            S.u0.a_off = (long)rt * 256 * (D / 2); S.u0.b_off = (long)b * D * (D / 2) + (long)(pn * 256) * (D / 2);
            pg8::EpiResB E{F.XA(), F.X2B(), 1.f / (PSCALE * MVSCALE)}; pg8::gemm_phase<pg8::EpiResB, pg8::OneUnit, true, true>(F.lds, g, S, E);
            if (PROBE_DUP == 7) { __syncthreads(); pg8::gemm_phase<pg8::EpiResB, pg8::OneUnit, true, true>(F.lds, g, S, E); } }
        SEAM(7); }
    if (IN(8)) { router_phase(F); if (PROBE_DUP == 8) { __syncthreads(); } SEAM(8); }
    if (IN(10)) {
        const MoeTab T = moe_tab(F); const int nt = moe_setup(F, T);
        pg8::StaticOrder S; S.init(nt, NGU / 256, F.G, (int)blockIdx.x, D / 2, D / 2, T.texp, MOE_WGM);
        { int tok[9]; float gt[9]; int gidx[9];
#pragma unroll
          for (int ui = 0; ui < 9; ++ui) { pg8::Unit u; tok[ui] = -1; gidx[ui] = -1; gt[ui] = 0.f;
              if (S.next(ui, u) && F.tid < 256) { const int e = u.aux, rank = u.pm * 256 + F.tid - T.pst[e]; const bool real = rank < T.cnt[e];
                  tok[ui] = real ? F.LTOK()[e * NTOK + rank] : 0;
                  if (u.pn == 0) { gidx[ui] = u.pm * 256 + F.tid; gt[ui] = real ? F.LGATE()[e * NTOK + rank] : 0.f; } } }
#pragma unroll
          for (int ui = 0; ui < 9; ++ui) { if (tok[ui] >= 0) T.gl[ui * 256 + F.tid] = tok[ui]; if (gidx[ui] >= 0) F.RGATE()[gidx[ui]] = gt[ui]; } }
        __syncthreads();
        pg8::Gemm g{(const bf16*)F.XB8(), (const bf16*)F.WguT8(), D / 2, D / 2, D / 2, T.gl};
        pg8::EpiGU E{F.ACT8(), F.b_gu()}; pg8::gemm_phase<pg8::EpiGU, pg8::StaticOrder, true, true>(F.lds, g, S, E);
        if (PROBE_DUP == 10) { __syncthreads(); pg8::gemm_phase<pg8::EpiGU, pg8::StaticOrder, true, true>(F.lds, g, S, E); }
        { const int rem = (nt * (NGU / 256)) % F.G, c = (int)blockIdx.x, nlw = rem ? F.G - rem : F.G;
          if (rem == 0 || c >= rem) { VM_WAIT(); __syncthreads();
              LAS unsigned* scr = (LAS unsigned*)(F.lds + F.wave * 16384); tr_run<true, true>(F, I_P1 + (rem ? c - rem : c) * NWAVES + F.wave, nlw * NWAVES, I_MOE, scr); } }
        if (PROBE_DUP == 110) { xcd_barrier(bar); pg8::gemm_phase<pg8::EpiGU, pg8::StaticOrder, true, true>(F.lds, g, S, E); }
        SEAM(10); }
    if (IN(11)) {
        const MoeTab T = moe_tab(F); const int nt = IN(10) ? (T.pst[NE] >> 8) : moe_setup(F, T);
        pg8::Gemm g{(const bf16*)F.ACT8(), (const bf16*)F.WdT8(), D / 2, D / 2, D / 2}; pg8::StaticOrder S; S.init(nt, D / 256, F.G, (int)blockIdx.x, D / 2, D / 2, T.texp, MOE_WGM);
        pg8::EpiDown E{(unsigned char*)F.Y(), F.b_down(), F.RGATE()}; pg8::gemm_phase<pg8::EpiDown, pg8::StaticOrder, true, true>(F.lds, g, S, E);
        if (PROBE_DUP == 11) { __syncthreads(); pg8::gemm_phase<pg8::EpiDown, pg8::StaticOrder, true, true>(F.lds, g, S, E); }
        SEAM(11); }
    if (IN(12)) { const MoeTab T = moe_tab(F); if (!IN(10)) (void)moe_setup(F, T); if (PROBE_DUP == 12) final_phase(F, (float*)F.ACT8(), T.pst); final_phase(F, F.out(), T.pst); }
#undef IN
#undef SEAM
}

#ifndef ONE_LAUNCH
#define ONE_LAUNCH 1
#endif
extern "C" void kernel_launch(void* const* d_in, const int* in_sizes, int n_in, void* d_out, int out_size, void* d_ws, size_t ws_size, hipStream_t stream) {
    static int grid = 0;
    if (grid == 0) {
        if (n_in != 21 || in_sizes[0] != NTOK * D || out_size != NTOK * D || ws_size < WS_END) { fprintf(stderr, "kernel_launch: unexpected shapes (n_in %d, in0 %d, out %d, ws %zu); nothing launched\n", n_in, n_in > 0 ? in_sizes[0] : -1, out_size, ws_size); grid = -1; return; }
        if (hipFuncSetAttribute((const void*)fwd_kernel, hipFuncAttributeMaxDynamicSharedMemorySize, LDS_BYTES) != hipSuccess) { fprintf(stderr, "kernel_launch: hipFuncSetAttribute failed\n"); grid = -1; return; }
        int dev = 0, cus = 0, per_cu = 0;
        (void)hipGetDevice(&dev); (void)hipDeviceGetAttribute(&cus, hipDeviceAttributeMultiprocessorCount, dev);
        if (hipOccupancyMaxActiveBlocksPerMultiprocessor(&per_cu, (const void*)fwd_kernel, NWAVES * 64, LDS_BYTES) != hipSuccess || per_cu < 1) fprintf(stderr, "kernel_launch: occupancy query reports %d blocks per CU\n", per_cu);
        (void)hipGetLastError();
        grid = 256;
        if (cus < 256) fprintf(stderr, "kernel_launch: device has %d CUs; this kernel needs 256 co-resident workgroups\n", cus);
    }
    if (grid < 0) return;
    (void)hipMemsetAsync((char*)d_ws + WS_CTL + CTL_ZERO_OFF, 0, CTL_ZERO_BYTES, stream);
    Args a{};
    for (int i = 0; i < 21; ++i) a.in[i] = (const float*)d_in[i];
    a.out = (float*)d_out; a.ws = (unsigned char*)d_ws;
#if ONE_LAUNCH
    a.ph_lo = 0; a.ph_hi = NPHASE;
    hipLaunchKernelGGL(fwd_kernel, dim3(grid), dim3(NWAVES * 64), LDS_BYTES, stream, a);
#else
    for (int p = 0; p < NPHASE; ++p) { a.ph_lo = p; a.ph_hi = p + 1; hipLaunchKernelGGL(fwd_kernel, dim3(grid), dim3(NWAVES * 64), LDS_BYTES, stream, a); }
#endif
}
```
